# Optimizing an MI355X kernel written in HIP

```python
import jax, jax.numpy as jnp
from jax import lax
import numpy as np

D_MODEL = 1024
BATCH = 2
SEQ = 8192
DEPTH = 4
DEC_BATCH = 128
DEC_SEQ = 1
PAST_LEN = 8192
PAGE_SIZE = 128

N_META = 16
WINDOW = 128
HEAD_DIM = 64
ATT_WIDTH = D_MODEL // 2
ATT_HEADS = ATT_WIDTH // HEAD_DIM
KV_HEADS = ATT_HEADS // 4
GQA_GROUP = ATT_HEADS // KV_HEADS
HG_WIDTH = D_MODEL - ATT_WIDTH
HG_EXPAND = 128
HG_HEADS = HG_WIDTH // HG_EXPAND
HG_KDIM = HG_EXPAND
HG_VDIM = HG_WIDTH // HG_HEADS
HG_CHUNK = 64
MIX_WIDTH = ATT_WIDTH + HG_WIDTH
PROJ_WIDTH = 2 * ATT_WIDTH + 2 * KV_HEADS * HEAD_DIM + 2 * HG_HEADS * HG_KDIM + 2 * HG_WIDTH
EPS = 1e-6
NEG_BIG = -1e30
TINY = 1e-30

kernel_name = "hymba_swa_sink_hgrn2_decode_step"


def rms_norm(x, w):
    x32 = x.astype(jnp.float32)
    y = x32 * lax.rsqrt(jnp.mean(x32 * x32, axis=-1, keepdims=True) + EPS) * w.astype(jnp.float32)
    return y.astype(x.dtype)


def project(x, norm_w, w_in, q_norm_w, k_norm_w, lb):
    lead = x.shape[:-1]
    p = rms_norm(x, norm_w) @ w_in
    sizes = [ATT_WIDTH, KV_HEADS * HEAD_DIM, KV_HEADS * HEAD_DIM, ATT_WIDTH,
             HG_HEADS * HG_KDIM, HG_HEADS * HG_KDIM, HG_WIDTH, HG_WIDTH]
    qa, ka, va, ga, qh, fh, ih, gh = jnp.split(p, np.cumsum(sizes)[:-1].tolist(), axis=-1)
    qa = rms_norm(qa.reshape(*lead, KV_HEADS, GQA_GROUP, HEAD_DIM), q_norm_w)
    ka = rms_norm(ka.reshape(*lead, KV_HEADS, HEAD_DIM), k_norm_w)
    va = va.reshape(*lead, KV_HEADS, HEAD_DIM)
    hq = jax.nn.silu(qh.astype(jnp.float32)).reshape(*lead, HG_HEADS, HG_KDIM)
    z = fh.astype(jnp.float32).reshape(*lead, HG_HEADS, HG_KDIM)
    hk = (1.0 - lb) * jax.nn.sigmoid(-z)
    f = lb + (1.0 - lb) * jax.nn.sigmoid(z)
    hg = jnp.log(jnp.maximum(f, TINY))
    hv = ih.astype(jnp.float32).reshape(*lead, HG_HEADS, HG_VDIM)
    return qa, ka, va, ga, hq, hk, hv, hg, gh


def window_mask(qpos, kpos):
    qq = qpos[..., :, None]
    meta = jnp.arange(N_META) <= qq
    kk = kpos[..., None, :]
    band = (kk >= N_META) & (kk <= qq) & (qq - kk < WINDOW)
    return jnp.concatenate([meta, band], axis=-1)


def sink_attention(q, k, v, mask, sink):
    s = jnp.einsum('bnqhgd,bnchd->bnhgqc', q, k).astype(jnp.float32) * (HEAD_DIM ** -0.5)
    s = jnp.where(mask[None, :, None, None], s, NEG_BIG)
    sink_col = jnp.broadcast_to(sink.astype(jnp.float32).reshape(1, 1, KV_HEADS, GQA_GROUP, 1, 1), s.shape[:-1] + (1,))
    prob = jax.nn.softmax(jnp.concatenate([s, sink_col], axis=-1), axis=-1)[..., :-1]
    return jnp.einsum('bnhgqc,bnchd->bnqhgd', prob.astype(v.dtype), v)


def window_attention_prompt(q, k, v, sink):
    B, L = q.shape[:2]
    nb = -(-L // WINDOW)
    pad = nb * WINDOW - L
    padf = lambda a: jnp.pad(a, [(0, 0), (0, pad)] + [(0, 0)] * (a.ndim - 2))
    qb = padf(q).reshape(B, nb, WINDOW, KV_HEADS, GQA_GROUP, HEAD_DIM)
    kb = padf(k).reshape(B, nb, WINDOW, KV_HEADS, HEAD_DIM)
    vb = padf(v).reshape(B, nb, WINDOW, KV_HEADS, HEAD_DIM)
    band = lambda a: jnp.concatenate([jnp.pad(a, [(0, 0), (1, 0), (0, 0), (0, 0), (0, 0)])[:, :-1], a], axis=2)
    meta = lambda a: jnp.broadcast_to(a[:, None, :N_META], (B, nb, N_META, KV_HEADS, HEAD_DIM))
    keys = jnp.concatenate([meta(k), band(kb)], axis=2)
    vals = jnp.concatenate([meta(v), band(vb)], axis=2)
    blk = jnp.arange(nb)[:, None]
    qpos = blk * WINDOW + jnp.arange(WINDOW)[None]
    kpos = (blk - 1) * WINDOW + jnp.arange(2 * WINDOW)[None]
    o = sink_attention(qb, keys, vals, window_mask(qpos, kpos), sink)
    return o.reshape(B, nb * WINDOW, KV_HEADS, GQA_GROUP, HEAD_DIM)[:, :L]


def window_attention_sample(q, k, v, meta_k, meta_v, buf_k, buf_v, sink):
    T = q.shape[1]
    wb = buf_k.shape[1]
    qpos = PAST_LEN + jnp.arange(T)
    kpos = jnp.concatenate([PAST_LEN - wb + jnp.arange(wb), PAST_LEN + jnp.arange(T)])
    keys = jnp.concatenate([meta_k, buf_k, k], axis=1)[:, None]
    vals = jnp.concatenate([meta_v, buf_v, v], axis=1)[:, None]
    return sink_attention(q[:, None], keys, vals, window_mask(qpos, kpos)[None], sink)[:, 0]


def hgrn_chunk(S0, q, k, v, g):
    C = q.shape[1]
    G = jnp.cumsum(g, axis=1)
    o_inter = jnp.einsum('bthk,bhkv->bthv', q * jnp.exp(G), S0)
    causal = jnp.tril(jnp.ones((C, C), dtype=bool))[None, :, :, None, None]
    diff = G[:, :, None] - G[:, None, :]
    decay = jnp.where(causal, jnp.exp(jnp.where(causal, diff, 0.0)), 0.0)
    A = jnp.einsum('btshk,bthk,bshk->btsh', decay, q, k)
    o = o_inter + jnp.einsum('btsh,bshv->bthv', A, v)
    G_end = G[:, -1]
    S1 = jnp.exp(G_end)[..., None] * S0 + jnp.einsum('bshk,bshv->bhkv', k * jnp.exp(G_end[:, None] - G), v)
    return S1, o


def hgrn_prompt(q, k, v, g):
    B = q.shape[0]
    S0 = jnp.zeros((B, HG_HEADS, HG_KDIM, HG_VDIM), jnp.float32)
    S, o_meta = hgrn_chunk(S0, q[:, :N_META], k[:, :N_META], v[:, :N_META], g[:, :N_META])
    nc = (q.shape[1] - N_META) // HG_CHUNK
    to_chunks = lambda a: jnp.moveaxis(a[:, N_META:].reshape(B, nc, HG_CHUNK, *a.shape[2:]), 1, 0)
    S, o_real = lax.scan(lambda s, xs: hgrn_chunk(s, *xs), S, (to_chunks(q), to_chunks(k), to_chunks(v), to_chunks(g)))
    o_real = jnp.moveaxis(o_real, 0, 1).reshape(B, nc * HG_CHUNK, HG_HEADS, HG_VDIM)
    return jnp.concatenate([o_meta, o_real], axis=1), S


def merge(att_o, ga, hg_o, gh, hg_norm_w, w_out):
    lead = ga.shape[:-1]
    att = att_o.reshape(*lead, ATT_WIDTH) * jax.nn.silu(ga)
    hg = rms_norm(hg_o, hg_norm_w).reshape(*lead, HG_WIDTH).astype(gh.dtype) * jax.nn.silu(gh)
    return jnp.concatenate([att, hg], axis=-1) @ w_out


def setup_inputs(seed: int = 0) -> dict:
    key = jax.random.key(seed)
    ks = jax.random.split(key, 18)
    nrm = jax.random.normal
    w_buf = min(WINDOW, PAST_LEN)
    return {
        "x_prompt": nrm(ks[0], (BATCH, SEQ, D_MODEL), jnp.float32),
        "x_sample": nrm(ks[1], (DEC_BATCH, DEC_SEQ, D_MODEL), jnp.float32),
        "cache_win_k": nrm(ks[2], (DEC_BATCH, DEPTH, w_buf, KV_HEADS, HEAD_DIM), jnp.float32),
        "cache_win_v": nrm(ks[3], (DEC_BATCH, DEPTH, w_buf, KV_HEADS, HEAD_DIM), jnp.float32),
        "cache_meta_k": nrm(ks[4], (DEC_BATCH, DEPTH, N_META, KV_HEADS, HEAD_DIM), jnp.float32),
        "cache_meta_v": nrm(ks[5], (DEC_BATCH, DEPTH, N_META, KV_HEADS, HEAD_DIM), jnp.float32),
        "state_hgrn": 0.5 * nrm(ks[6], (DEC_BATCH, DEPTH, HG_HEADS, HG_KDIM, HG_VDIM), jnp.float32),
        "meta_tokens": nrm(ks[7], (N_META, D_MODEL), jnp.float32),
        "norm_w": 1.0 + 0.02 * nrm(ks[8], (DEPTH, D_MODEL), jnp.float32),
        "w_in": nrm(ks[9], (DEPTH, D_MODEL, PROJ_WIDTH), jnp.float32) * D_MODEL ** -0.5,
        "q_norm_w": 1.0 + 0.02 * nrm(ks[10], (DEPTH, HEAD_DIM), jnp.float32),
        "k_norm_w": 1.0 + 0.02 * nrm(ks[11], (DEPTH, HEAD_DIM), jnp.float32),
        "attn_sinks": 0.5 * nrm(ks[12], (DEPTH, ATT_HEADS), jnp.float32),
        "hg_lb_logits": 0.1 * nrm(ks[13], (DEPTH, HG_HEADS * HG_KDIM), jnp.float32),
        "hg_norm_w": 1.0 + 0.02 * nrm(ks[14], (DEPTH, HG_VDIM), jnp.float32),
        "w_out": nrm(ks[15], (DEPTH, MIX_WIDTH, D_MODEL), jnp.float32) * MIX_WIDTH ** -0.5,
    }


def reference(x_prompt, x_sample, cache_win_k, cache_win_v, cache_meta_k, cache_meta_v, state_hgrn,
              meta_tokens, norm_w, w_in, q_norm_w, k_norm_w, attn_sinks, hg_lb_logits, hg_norm_w, w_out):
    lb_p = jax.nn.softmax(hg_lb_logits.astype(jnp.float32), axis=0)
    lb_all = (jnp.cumsum(lb_p, axis=0) - lb_p[0]).reshape(DEPTH, HG_HEADS, HG_KDIM)
    B = x_prompt.shape[0]
    w_buf = cache_win_k.shape[2]
    xp = jnp.concatenate([jnp.broadcast_to(meta_tokens[None].astype(x_prompt.dtype), (B, N_META, D_MODEL)), x_prompt], axis=1)
    xs = x_sample
    wkp, wvp, mkp, mvp, hsp, wks, wvs, hss = [], [], [], [], [], [], [], []
    for l in range(DEPTH):
        qa, ka, va, ga, hq, hk, hv, hg, gh = project(xp, norm_w[l], w_in[l], q_norm_w[l], k_norm_w[l], lb_all[l])
        att = window_attention_prompt(qa, ka, va, attn_sinks[l])
        hgo, S_p = hgrn_prompt(hq, hk, hv, hg)
        xp = xp + merge(att, ga, hgo, gh, hg_norm_w[l], w_out[l])
        wkp.append(ka[:, -w_buf:]); wvp.append(va[:, -w_buf:])
        mkp.append(ka[:, :N_META]); mvp.append(va[:, :N_META])
        hsp.append(S_p)
        qa, ka, va, ga, hq, hk, hv, hg, gh = project(xs, norm_w[l], w_in[l], q_norm_w[l], k_norm_w[l], lb_all[l])
        att = window_attention_sample(qa, ka, va, cache_meta_k[:, l], cache_meta_v[:, l], cache_win_k[:, l], cache_win_v[:, l], attn_sinks[l])
        S_s, hgo = hgrn_chunk(state_hgrn[:, l].astype(jnp.float32), hq, hk, hv, hg)
        xs = xs + merge(att, ga, hgo, gh, hg_norm_w[l], w_out[l])
        wks.append(jnp.concatenate([cache_win_k[:, l], ka], axis=1)[:, -w_buf:])
        wvs.append(jnp.concatenate([cache_win_v[:, l], va], axis=1)[:, -w_buf:])
        hss.append(S_s)
    y_prompt = xp[:, N_META:]
    y_sample = xs
    return (y_prompt, y_sample, jnp.stack(wkp, 1), jnp.stack(wvp, 1), jnp.stack(mkp, 1), jnp.stack(mvp, 1), jnp.stack(hsp, 1),
            jnp.stack(wks, 1), jnp.stack(wvs, 1), jnp.stack(hss, 1))
```

```cpp
#include <hip/hip_runtime.h>
#include <hip/hip_cooperative_groups.h>
#include <cstdio>
#include <cstdint>
namespace pg8 {
#define PG8_LAS __attribute__((address_space(3)))
typedef unsigned short bf16_t;
typedef short bf16x8 __attribute__((ext_vector_type(8)));
typedef float f32x4 __attribute__((ext_vector_type(4)));
typedef unsigned u32x4 __attribute__((ext_vector_type(4)));
constexpr int BM = 256, BK = 64, HALF = 128, HTB = HALF * BK * 2  , STAGE_BYTES = 8 * HTB, NXCD = 8, WGM = 8;

__host__ __device__ __forceinline__ int lds_byte(int r, int c) { const int st = (r >> 4) * 2 + (c >> 5), rr = r & 15, cc = c & 31, ob = rr * 64 + cc * 2; return st * 1024 + (ob ^ (((ob >> 9) & 1) << 5)); }
__host__ __device__ __forceinline__ void stage_rc(int b, int& R, int& C) { const int st = b / 1024, sb = b % 1024, swz = sb ^ (((sb >> 9) & 1) << 5); R = (st >> 1) * 16 + swz / 64; C = (st & 1) * 32 + (swz % 64) / 2; }
__host__ __device__ __forceinline__ int perm32(int rho) { const int n = rho >> 4, i = rho & 15; return 8 * (i >> 2) + 4 * n + (i & 3); }

struct Unit { int pm, pn; };
struct Gemm { const bf16_t* A; const bf16_t* Bt; int M, N, K; };

struct StaticOrder {
    int nM, nN, nwg, G, c;
    __host__ __device__ void init(int M, int N, int G_, int c_) { nM = M / BM; nN = N / BM; nwg = nM * nN; G = G_; c = c_; }
    __host__ __device__ bool next(int i, Unit& u) const {
        const long L = (long)i * G + c; if (L >= nwg) return false;
        int wgid = (int)L; { const int q = nwg / NXCD, r = nwg % NXCD, xcd = wgid % NXCD, off = wgid / NXCD; wgid = (xcd < r ? xcd * (q + 1) : r * (q + 1) + (xcd - r) * q) + off; }
        const int nig = WGM * nN, gid = wgid / nig, fm = gid * WGM, gsz = (nM - fm) < WGM ? (nM - fm) : WGM;
        u.pm = fm + ((wgid % nig) % gsz); u.pn = (wgid % nig) / gsz; return true;
    }
    __device__ __forceinline__ void a_ready(const Unit&) const {}
    __device__ __forceinline__ void done(const Unit&) const {}
};
__device__ __forceinline__ unsigned cvt_pk_bf16(float lo, float hi) { unsigned r; asm volatile("v_cvt_pk_bf16_f32 %0, %1, %2" : "=v"(r) : "v"(lo), "v"(hi)); return r; }
template <class Epi, class Sched, bool ALIGN_EPI = false, bool SP2 = false>
__device__ __forceinline__ void gemm_phase(PG8_LAS unsigned char* lds, const Gemm g, const Sched& S, const Epi& E) {
    int tid_ = threadIdx.x; asm volatile("" : "+v"(tid_)); const int tid = tid_, wid = __builtin_amdgcn_readfirstlane(tid >> 6), lane = tid & 63, wr = wid >> 2, wc = wid & 3, fr = lane & 15, fq = lane >> 4;
    const int K = g.K, nt = K / BK;
    unsigned voffA[2], voffB[2];
#pragma unroll
    for (int i = 0; i < 2; ++i) { int R, C; stage_rc(tid * 16 + i * 8192, R, C); const int Rb = Epi::PERM ? ((R & ~31) + perm32(R & 31)) : R;
        voffA[i] = (unsigned)(R * K + C) * 2u; voffB[i] = (unsigned)(Rb * K + C) * 2u; }
    const size_t kstep = (size_t)(BK * 2);
    const size_t hstep = (size_t)HALF * K * 2;
    const size_t tstep = 2 * hstep;
    const unsigned ldsw = (unsigned)wid * 1024u;
    const int aoff = lds_byte(wr * 64 + fr, fq * 8), boff = lds_byte(wc * 32 + fr, fq * 8);
#define PG8_SA(b, h) (((b) * 2 + (h)) * HTB)
#define PG8_SB(b, h) ((4 + (b) * 2 + (h)) * HTB)
#define PG8_STAGE(bufoff, gbase, voff) do { _Pragma("unroll") for (int _i = 0; _i < 2; ++_i) \
        __builtin_amdgcn_global_load_lds((const unsigned*)((const char*)(gbase) + (voff)[_i]), (PG8_LAS unsigned*)(lds + (bufoff) + ldsw + _i * 8192), 16, 0, 0); } while (0)
#define PG8_LDA(dst, b, h) do { _Pragma("unroll") for (int m = 0; m < 4; ++m) _Pragma("unroll") for (int k = 0; k < 2; ++k) dst[m][k] = *(const PG8_LAS bf16x8*)(lds + PG8_SA(b, h) + aoff + m * 2048 + k * 1024); } while (0)
#define PG8_LDB(dst, b, h) do { _Pragma("unroll") for (int n = 0; n < 2; ++n) _Pragma("unroll") for (int k = 0; k < 2; ++k) dst[n][k] = *(const PG8_LAS bf16x8*)(lds + PG8_SB(b, h) + boff + n * 2048 + k * 1024); } while (0)
#define PG8_MMA(ai, bj, At, Bt) do { __builtin_amdgcn_s_setprio(1); _Pragma("unroll") for (int m = 0; m < 4; ++m) _Pragma("unroll") for (int n = 0; n < 2; ++n) _Pragma("unroll") for (int k = 0; k < 2; ++k) \
        acc[ai][bj][m][n] = __builtin_amdgcn_mfma_f32_16x16x32_bf16(Bt[n][k], At[m][k], acc[ai][bj][m][n], 0, 0, 0); __builtin_amdgcn_s_setprio(0); } while (0)
#define PG8_WAIT_V(n) asm volatile("s_waitcnt vmcnt(" #n ")" ::: "memory")
#define PG8_WAIT_L(n) asm volatile("s_waitcnt lgkmcnt(" #n ")" ::: "memory")
#define PG8_BAR __builtin_amdgcn_s_barrier()
#define PG8_SCHED __builtin_amdgcn_sched_barrier(0)
    Unit cur, nxt; int ui = 0;
    if (!S.next(0, cur)) return;
    f32x4 acc[2][2][4][2];
#pragma unroll
    for (int a = 0; a < 2; ++a)
#pragma unroll
        for (int b = 0; b < 2; ++b)
#pragma unroll
            for (int m = 0; m < 4; ++m)
#pragma unroll
                for (int n = 0; n < 2; ++n) acc[a][b][m][n] = (f32x4){0.f, 0.f, 0.f, 0.f};
    bf16x8 At[4][2], B0[2][2], B1[2][2];
    const char* cA = (const char*)g.A + (size_t)cur.pm * tstep; const char* cB = (const char*)g.Bt + (size_t)cur.pn * tstep;
    S.a_ready(cur);
    if constexpr (SP2) {
        PG8_STAGE(PG8_SB(0, 0), cB, voffB); PG8_STAGE(PG8_SB(0, 1), cB + hstep, voffB); PG8_STAGE(PG8_SA(0, 0), cA, voffA); PG8_STAGE(PG8_SA(0, 1), cA + hstep, voffA);
        if (wr == 1) PG8_BAR;
        PG8_WAIT_V(2); PG8_BAR;
        PG8_STAGE(PG8_SB(1, 0), cB + kstep, voffB); PG8_STAGE(PG8_SA(1, 0), cA + kstep, voffA); PG8_STAGE(PG8_SB(1, 1), cB + hstep + kstep, voffB);
        PG8_WAIT_V(6); PG8_BAR;
    } else {
        PG8_STAGE(PG8_SB(0, 0), cB, voffB); PG8_STAGE(PG8_SA(0, 0), cA, voffA); PG8_STAGE(PG8_SB(0, 1), cB + hstep, voffB); PG8_STAGE(PG8_SA(0, 1), cA + hstep, voffA);
        if (wr == 1) PG8_BAR;
        PG8_WAIT_V(4); PG8_BAR;
        PG8_STAGE(PG8_SB(1, 0), cB + kstep, voffB); PG8_STAGE(PG8_SA(1, 0), cA + kstep, voffA); PG8_STAGE(PG8_SB(1, 1), cB + hstep + kstep, voffB);
        PG8_WAIT_V(6); PG8_BAR;
    }
    for (;;) {
        const bool has_next = S.next(ui + 1, nxt);
        const char* nA = has_next ? (const char*)g.A + (size_t)nxt.pm * tstep : cA; const char* nB = has_next ? (const char*)g.Bt + (size_t)nxt.pn * tstep : cB;
        for (int t = 0; t < nt; t += 2) {
            const bool last = (t == nt - 2);
            const char* a1 = cA + (size_t)(t + 1) * kstep;
            const char* a2 = last ? nA : cA + (size_t)(t + 2) * kstep; const char* b2 = last ? nB : cB + (size_t)(t + 2) * kstep;
            const char* a3 = a2 + kstep; const char* b3 = b2 + kstep;
            if (last && has_next) S.a_ready(nxt);
            if constexpr (SP2) {
            PG8_LDB(B0, 0, 0); PG8_LDB(B1, 0, 1); PG8_SCHED; PG8_LDA(At, 0, 0); PG8_STAGE(PG8_SA(1, 1), a1 + hstep, voffA);
            PG8_WAIT_V(8); PG8_WAIT_L(0); PG8_BAR; PG8_MMA(0, 0, At, B0); PG8_MMA(0, 1, At, B1); PG8_BAR; PG8_SCHED;
            PG8_LDA(At, 0, 1); PG8_STAGE(PG8_SB(0, 0), b2, voffB); PG8_STAGE(PG8_SB(0, 1), b2 + hstep, voffB); PG8_STAGE(PG8_SA(0, 0), a2, voffA);
            PG8_WAIT_V(8); PG8_WAIT_L(0); PG8_BAR; PG8_MMA(1, 0, At, B0); PG8_MMA(1, 1, At, B1); PG8_BAR; PG8_SCHED;
            PG8_LDB(B0, 1, 0); PG8_LDB(B1, 1, 1); PG8_SCHED; PG8_LDA(At, 1, 0); PG8_STAGE(PG8_SA(0, 1), a2 + hstep, voffA);
            PG8_WAIT_V(8); PG8_WAIT_L(0); PG8_BAR; PG8_MMA(0, 0, At, B0); PG8_MMA(0, 1, At, B1); PG8_BAR; PG8_SCHED;
            PG8_LDA(At, 1, 1); PG8_STAGE(PG8_SB(1, 0), b3, voffB); PG8_STAGE(PG8_SB(1, 1), b3 + hstep, voffB); PG8_STAGE(PG8_SA(1, 0), a3, voffA);
            PG8_WAIT_V(8); PG8_WAIT_L(0); PG8_BAR; PG8_MMA(1, 0, At, B0); PG8_MMA(1, 1, At, B1); PG8_BAR; PG8_SCHED;
            } else {
            PG8_LDB(B0, 0, 0); PG8_SCHED; PG8_LDA(At, 0, 0); PG8_STAGE(PG8_SA(1, 1), a1 + hstep, voffA);
            PG8_WAIT_L(8); PG8_BAR; PG8_WAIT_L(0); PG8_MMA(0, 0, At, B0); PG8_BAR; PG8_SCHED;
            PG8_LDB(B1, 0, 1); PG8_STAGE(PG8_SB(0, 0), b2, voffB);
            PG8_BAR; PG8_WAIT_L(0); PG8_MMA(0, 1, At, B1); PG8_BAR;
            PG8_LDA(At, 0, 1); PG8_STAGE(PG8_SA(0, 0), a2, voffA);
            PG8_BAR; PG8_WAIT_L(0); PG8_MMA(1, 0, At, B0); PG8_BAR; PG8_SCHED;
            PG8_STAGE(PG8_SB(0, 1), b2 + hstep, voffB);
            PG8_WAIT_V(6); PG8_BAR; PG8_MMA(1, 1, At, B1); PG8_BAR;
            PG8_LDB(B0, 1, 0); PG8_SCHED; PG8_LDA(At, 1, 0); PG8_STAGE(PG8_SA(0, 1), a2 + hstep, voffA);
            PG8_WAIT_L(8); PG8_BAR; PG8_WAIT_L(0); PG8_MMA(0, 0, At, B0); PG8_BAR; PG8_SCHED;
            PG8_LDB(B1, 1, 1); PG8_STAGE(PG8_SB(1, 0), b3, voffB);
            PG8_BAR; PG8_WAIT_L(0); PG8_MMA(0, 1, At, B1); PG8_BAR;
            PG8_LDA(At, 1, 1); PG8_STAGE(PG8_SA(1, 0), a3, voffA);
            PG8_BAR; PG8_WAIT_L(0); PG8_MMA(1, 0, At, B0); PG8_BAR; PG8_SCHED;
            PG8_STAGE(PG8_SB(1, 1), b3 + hstep, voffB);
            PG8_WAIT_V(6); PG8_BAR; PG8_MMA(1, 1, At, B1); PG8_BAR;
            }
        }
        if constexpr (ALIGN_EPI) { if (wr == 0) PG8_BAR; }
        if constexpr (!Epi::AFTER_DRAIN) { E(acc, cur, wr, wc, fr, fq); S.done(cur); }
        if (!has_next) break;
#pragma unroll
        for (int a = 0; a < 2; ++a)
#pragma unroll
            for (int b = 0; b < 2; ++b)
#pragma unroll
                for (int m = 0; m < 4; ++m)
#pragma unroll
                    for (int n = 0; n < 2; ++n) acc[a][b][m][n] = (f32x4){0.f, 0.f, 0.f, 0.f};
        cur = nxt; cA = nA; cB = nB; ++ui;
        if constexpr (ALIGN_EPI) { if (wr == 1) PG8_BAR; }
    }
    PG8_WAIT_V(0);
    if constexpr (!ALIGN_EPI) { if (wr == 0) PG8_BAR; }
    PG8_BAR;
    if constexpr (Epi::AFTER_DRAIN) { E.fused(acc, cur, wr, wc, fr, fq, lds, wid, lane); S.done(cur); }
#undef PG8_SA
#undef PG8_SB
#undef PG8_STAGE
#undef PG8_LDA
#undef PG8_LDB
#undef PG8_MMA
#undef PG8_WAIT_V
#undef PG8_WAIT_L
#undef PG8_BAR
#undef PG8_SCHED
}
}

namespace cg = cooperative_groups;
#define GAS __attribute__((address_space(1)))
#define LAS __attribute__((address_space(3)))
typedef unsigned short bf16;
typedef float f32x4 __attribute__((ext_vector_type(4)));
typedef short s16x8 __attribute__((ext_vector_type(8)));
typedef short s16x4 __attribute__((ext_vector_type(4)));
typedef unsigned u32x4 __attribute__((ext_vector_type(4)));
typedef unsigned u32x2 __attribute__((ext_vector_type(2)));

constexpr int DM = 1024, NB = 2, SEQ = 8192, DEPTH = 4, DB = 128, NMETA = 16, WIN = 128, HD = 64, NQH = 8, NKV = 2;
constexpr int HGH = 4, HK = 128, HV = 128, PW = 3328;
constexpr int LP = SEQ + NMETA;
constexpr int MP = NB * LP;
constexpr int MS = MP + DB;
constexpr int MPAD = 16640;
constexpr int C_QA = 0, C_KA = 512, C_VA = 640, C_GA = 768, C_QH = 1280, C_FH = 1792, C_IH = 2304, C_GH = 2816;
constexpr int NSC = 32;
constexpr float EPS = 1e-6f;
constexpr int NTHREADS = 512;
constexpr int LDS_BYTES = 163840;
constexpr int OLDS_OFF = 47104, OLDS_ROW = 264;
constexpr int QLDS_OFF = 118912, QLDS_ROW = 272;

constexpr size_t MiB = 1u << 20;
constexpr size_t WS_SS = 0, CTL_ZERO_BYTES = 1 * MiB;
constexpr float SS_SCALE = 16777216.f;
constexpr size_t WS_LB = 1 * MiB;
constexpr size_t WS_WIN = 2 * MiB;
constexpr size_t WS_WOUT = 28 * MiB;
constexpr size_t WS_XB = 36 * MiB;
constexpr size_t WS_X = 69 * MiB;
constexpr size_t WS_P = 134 * MiB;
constexpr size_t WS_MIX = 240 * MiB;
constexpr size_t WS_L = 273 * MiB;
constexpr size_t WS_D = 290 * MiB;
constexpr size_t WS_FLAG = 900 * 1024;
constexpr size_t WS_BAR = 768 * 1024;
constexpr size_t WS_QH = 291 * MiB;
constexpr size_t WS_OL = 308 * MiB;
constexpr size_t WS_S = 325 * MiB;
constexpr size_t WS_END = 342 * MiB;
constexpr int MISC_OFF = 159744;

constexpr size_t O_YP = 0, O_YS = O_YP + (size_t)NB * SEQ * DM, O_WKP = O_YS + (size_t)DB * DM, O_WVP = O_WKP + 131072, O_MKP = O_WVP + 131072,
                 O_MVP = O_MKP + 16384, O_HP = O_MVP + 16384, O_WKS = O_HP + 524288, O_WVS = O_WKS + 8388608, O_HS = O_WVS + 8388608, O_END = O_HS + 33554432;

struct Args { const float* in[16]; float* out; unsigned char* ws; int ph_lo, ph_hi; };

__device__ __forceinline__ float bflo(unsigned u) { return __builtin_bit_cast(float, u << 16); }
__device__ __forceinline__ float bfhi(unsigned u) { return __builtin_bit_cast(float, u & 0xffff0000u); }
__device__ __forceinline__ float bf2f(unsigned short h) { return __builtin_bit_cast(float, (unsigned)h << 16); }
__device__ __forceinline__ unsigned f2bf(float f) { unsigned u = __builtin_bit_cast(unsigned, f); return (u + 0x7fffu + ((u >> 16) & 1u)) >> 16; }
typedef float f32x2_t __attribute__((ext_vector_type(2)));
typedef __bf16 bf16x2_t __attribute__((ext_vector_type(2)));
__device__ __forceinline__ unsigned pk2(float lo, float hi) { f32x2_t v = {lo, hi}; bf16x2_t b = __builtin_convertvector(v, bf16x2_t); return __builtin_bit_cast(unsigned, b); }
__device__ __forceinline__ unsigned pk2s(float lo, float hi) {
    const unsigned a = __builtin_bit_cast(unsigned, lo) + 0x8000u, b = __builtin_bit_cast(unsigned, hi) + 0x8000u;
    return __builtin_amdgcn_perm(b, a, 0x07060302u);
}
__device__ __forceinline__ f32x4 zero_acc() { f32x4 z = {0.f, 0.f, 0.f, 0.f}; asm volatile("" : "+v"(z)); return z; }
__device__ __forceinline__ float silu_f(float x) { return x * __builtin_amdgcn_rcpf(1.f + __expf(-x)); }
__device__ __forceinline__ float wave_sum(float v) {
#pragma unroll
    for (int o = 1; o < 64; o <<= 1) v += __shfl_xor(v, o);
    return v;
}
__device__ __forceinline__ float wave_max(float v) {
#pragma unroll
    for (int o = 1; o < 64; o <<= 1) v = fmaxf(v, __shfl_xor(v, o));
    return v;
}
#define MFMA32(a, b, c) __builtin_amdgcn_mfma_f32_16x16x32_bf16((a), (b), (c), 0, 0, 0)
#define MFMA_DRAIN() do { __builtin_amdgcn_sched_barrier(0); asm volatile("s_nop 15\n\ts_nop 15"); __builtin_amdgcn_sched_barrier(0); } while (0)
#define CVT_GAP() do { __builtin_amdgcn_sched_barrier(0); asm volatile("s_nop 3"); __builtin_amdgcn_sched_barrier(0); } while (0)
#define MFMA16(a, b, c) __builtin_amdgcn_mfma_f32_16x16x16bf16_1k((a), (b), (c), 0, 0, 0)
#define LDS_WAIT() asm volatile("s_waitcnt lgkmcnt(0)" ::: "memory")

struct EpiP {
    static constexpr bool PERM = true, AFTER_DRAIN = false;
    bf16* P; const unsigned long long* ss;
    __device__ __forceinline__ void operator()(const pg8::f32x4 (&acc)[2][2][4][2], const pg8::Unit& u, int wr, int wc, int fr, int fq) const {
        const int row0 = u.pm * 256 + wr * 64 + fr, col0 = u.pn * 256 + wc * 32 + 8 * fq;
        unsigned long long sv[8];
#pragma unroll
        for (int g = 0; g < 8; ++g) sv[g] = ss[row0 + (g >> 2) * 128 + (g & 3) * 16];
#pragma unroll
        for (int ai = 0; ai < 2; ++ai)
#pragma unroll
            for (int m = 0; m < 4; ++m) {
                const int row = row0 + ai * 128 + m * 16;
                const float rs = rsqrtf((float)sv[ai * 4 + m] * (1.f / (SS_SCALE * DM)) + EPS);
                bf16* rowp = P + (size_t)row * PW + col0;
#pragma unroll
                for (int bj = 0; bj < 2; ++bj) {
                    const pg8::f32x4 v0 = acc[ai][bj][m][0] * rs, v1 = acc[ai][bj][m][1] * rs;
                    u32x4 w; w.x = pk2(v0[0], v0[1]); w.y = pk2(v0[2], v0[3]); w.z = pk2(v1[0], v1[1]); w.w = pk2(v1[2], v1[3]);
                    *(u32x4*)(rowp + bj * 128) = w;
                }
            }
    }
};
struct EpiOut {
    static constexpr bool PERM = true, AFTER_DRAIN = false;
    bf16* XB; unsigned long long* ssn; float* out; int last;
    __device__ __forceinline__ void operator()(const pg8::f32x4 (&acc)[2][2][4][2], const pg8::Unit& u, int wr, int wc, int fr, int fq) const {
        const int row0 = u.pm * 256 + wr * 64 + fr, col0 = u.pn * 256 + wc * 32 + 8 * fq;
#pragma unroll
        for (int ai = 0; ai < 2; ++ai) {
            u32x4 xv[1][4][2];
#pragma unroll
            for (int m = 0; m < 4; ++m) { const bf16* xr = XB + (size_t)(row0 + ai * 128 + m * 16) * DM + col0;
#pragma unroll
                for (int bj = 0; bj < 2; ++bj) xv[0][m][bj] = *(const u32x4*)(xr + bj * 128); }
#pragma unroll
            for (int m = 0; m < 4; ++m) {
                const int row = row0 + ai * 128 + m * 16;
                float part = 0.f;
                float* yr = nullptr;
                if (last) {
                    if (row < MP) { const int b = row / LP, pos = row - b * LP; if (pos >= NMETA) yr = out + O_YP + ((size_t)b * SEQ + pos - NMETA) * DM + col0; }
                    else if (row < MS) yr = out + O_YS + (size_t)(row - MP) * DM + col0;
                }
#pragma unroll
                for (int bj = 0; bj < 2; ++bj) {
                    const u32x4 xb = xv[0][m][bj];
                    const pg8::f32x4 x0 = {bflo(xb.x), bfhi(xb.x), bflo(xb.y), bfhi(xb.y)}, x1 = {bflo(xb.z), bfhi(xb.z), bflo(xb.w), bfhi(xb.w)};
                    const pg8::f32x4 v0 = x0 + acc[ai][bj][m][0], v1 = x1 + acc[ai][bj][m][1];
                    if (last) {
                        if (yr) { __builtin_nontemporal_store(v0, (pg8::f32x4*)(yr + bj * 128)); __builtin_nontemporal_store(v1, (pg8::f32x4*)(yr + bj * 128 + 4)); }
                    } else {
                        u32x4 w; w.x = pk2(v0[0], v0[1]); w.y = pk2(v0[2], v0[3]); w.z = pk2(v1[0], v1[1]); w.w = pk2(v1[2], v1[3]);
                        *(u32x4*)(XB + (size_t)row * DM + col0 + bj * 128) = w;
                        part += v0[0] * v0[0] + v0[1] * v0[1] + v0[2] * v0[2] + v0[3] * v0[3] + v1[0] * v1[0] + v1[1] * v1[1] + v1[2] * v1[2] + v1[3] * v1[3];
                    }
                }
                if (!last) {
                    part += __shfl_xor(part, 16); part += __shfl_xor(part, 32);
                    if (fq == 0) atomicAdd(ssn + row, (unsigned long long)(part * SS_SCALE));
                }
            }
        }
    }
};

struct OrderA {
    pg8::StaticOrder so; unsigned* flag;
    __device__ __forceinline__ bool next(int i, pg8::Unit& u) const {
        const long L = (long)i * so.G + so.c; if (L >= so.nwg) return false;
        pg8::StaticOrder t = so; t.c = (int)(so.nwg - 1 - L); t.G = so.nwg;
        return t.next(0, u);
    }
    __device__ __forceinline__ void a_ready(const pg8::Unit&) const {}
    __device__ __forceinline__ void done(const pg8::Unit& u) const {
        if (u.pm == MPAD / 256 - 1) {
            asm volatile("s_waitcnt vmcnt(0)" ::: "memory");
            __builtin_amdgcn_fence(__ATOMIC_RELEASE, "agent");
            asm volatile("s_waitcnt vmcnt(0)" ::: "memory");
            if ((threadIdx.x & 63) == 0) __hip_atomic_fetch_add(flag, 1u, __ATOMIC_RELAXED, __HIP_MEMORY_SCOPE_AGENT);
        }
    }
};
constexpr unsigned SAMPLE_P_WAVES = (PW / 256) * 8;

__device__ __forceinline__ void transpose_item(const float* W, int K, int N, bf16* WT, const float* scale, LAS float* scr, int item, int lane) {
    const int nblk = N / 32, kb = item / nblk, nb = item % nblk, k0 = 64 * kb, n0 = 32 * nb;
    float wv[32];
#pragma unroll
    for (int i = 0; i < 32; ++i) wv[i] = __builtin_nontemporal_load(W + (size_t)(k0 + 2 * i + (lane >> 5)) * N + n0 + (lane & 31));
#pragma unroll
    for (int i = 0; i < 32; ++i) { const int kk = 2 * i + (lane >> 5); const float s = scale ? scale[k0 + kk] : 1.f; scr[kk * 33 + (lane & 31)] = wv[i] * s; }
    LDS_WAIT();
    const int c = lane & 7;
#pragma unroll
    for (int j = 0; j < 4; ++j) { const int n = (lane >> 3) + 8 * j; const LAS float* s = scr + (8 * c) * 33 + n;
        u32x4 o; o.x = pk2(s[0 * 33], s[1 * 33]); o.y = pk2(s[2 * 33], s[3 * 33]); o.z = pk2(s[4 * 33], s[5 * 33]); o.w = pk2(s[6 * 33], s[7 * 33]);
        *(u32x4*)(WT + (size_t)(n0 + n) * K + k0 + 8 * c) = o; }
    LDS_WAIT();
}

__device__ __forceinline__ void prologue(const Args& a, LAS unsigned char* lds) {
    int tid_ = threadIdx.x; asm volatile("" : "+v"(tid_)); const int tid = tid_, lane = tid & 63, wave = tid >> 6, G = gridDim.x;
    const int gw = blockIdx.x * 8 + wave, NGW = G * 8;
    LAS float* scr = (LAS float*)(lds + wave * 8704);
    bf16* Win_t = (bf16*)(a.ws + WS_WIN);
    constexpr int I_IN = (DM / 64) * (PW / 32);
    for (int it = gw; it < I_IN; it += NGW) transpose_item(a.in[9], DM, PW, Win_t, a.in[8], scr, it, lane);
    bf16* XB = (bf16*)(a.ws + WS_XB); unsigned long long* ss0 = (unsigned long long*)(a.ws + WS_SS);
    for (int row0 = gw; row0 < MPAD; row0 += 4 * NGW) {
        f32x4 v[4][4]; float sq[4];
#pragma unroll
        for (int r = 0; r < 4; ++r) {
            const int row = row0 + r * NGW;
            const float* src = nullptr;
            if (row < MP) { const int b = row / LP, pos = row - b * LP; src = pos < NMETA ? a.in[7] + (size_t)pos * DM : a.in[0] + ((size_t)b * SEQ + pos - NMETA) * DM; }
            else if (row < MS) src = a.in[1] + (size_t)(row - MP) * DM;
#pragma unroll
            for (int j = 0; j < 4; ++j) v[r][j] = src ? __builtin_nontemporal_load((const f32x4*)src + lane + 64 * j) : (f32x4){0.f, 0.f, 0.f, 0.f};
        }
#pragma unroll
        for (int r = 0; r < 4; ++r) {
            float t = 0.f;
#pragma unroll
            for (int j = 0; j < 4; ++j) t += v[r][j][0] * v[r][j][0] + v[r][j][1] * v[r][j][1] + v[r][j][2] * v[r][j][2] + v[r][j][3] * v[r][j][3];
            sq[r] = wave_sum(t);
        }
#pragma unroll
        for (int r = 0; r < 4; ++r) {
            const int row = row0 + r * NGW;
            if (row < MPAD) {
#pragma unroll
                for (int j = 0; j < 4; ++j) { u32x2 w; w.x = pk2(v[r][j][0], v[r][j][1]); w.y = pk2(v[r][j][2], v[r][j][3]); *((u32x2*)(XB + (size_t)row * DM) + lane + 64 * j) = w; }
                if (lane == 0) ss0[row] = (unsigned long long)(sq[r] * SS_SCALE);
            }
        }
    }
    if (blockIdx.x == 0) {
        const float* lg = a.in[13]; float* lb = (float*)(a.ws + WS_LB);
        const float l0 = lg[tid], l1 = lg[512 + tid], l2 = lg[1024 + tid], l3 = lg[1536 + tid];
        const float mx = fmaxf(fmaxf(l0, l1), fmaxf(l2, l3));
        const float e0 = __expf(l0 - mx), e1 = __expf(l1 - mx), e2 = __expf(l2 - mx), e3 = __expf(l3 - mx), inv = 1.f / (e0 + e1 + e2 + e3);
        lb[tid] = 0.f; lb[512 + tid] = e1 * inv; lb[1024 + tid] = (e1 + e2) * inv; lb[1536 + tid] = (e1 + e2 + e3) * inv;
    }
    __syncthreads();
}

__device__ __forceinline__ void convert_layer(const Args& a, int l, int first, LAS unsigned char* lds) {
    int tid_ = threadIdx.x; asm volatile("" : "+v"(tid_)); const int tid = tid_, lane = tid & 63, wave = tid >> 6;
    const int G = gridDim.x, nb = G - first, me = (int)blockIdx.x - first;
    if (me < 0 || nb <= 0) return;
    LAS float* scr = (LAS float*)(lds + wave * 8704);
    constexpr int I_IN = (DM / 64) * (PW / 32), I_OUT = (DM / 64) * (DM / 32);
    const int li = l + 1, n_in = (li < DEPTH) ? I_IN : 0;
    bf16* Win_t = (bf16*)(a.ws + WS_WIN) + (size_t)li * PW * DM; bf16* Wout_t = (bf16*)(a.ws + WS_WOUT) + (size_t)l * DM * DM;
    for (int it = me * 8 + wave; it < I_OUT + n_in; it += nb * 8) {
        if (it < I_OUT) transpose_item(a.in[15] + (size_t)l * DM * DM, DM, DM, Wout_t, nullptr, scr, it, lane);
        else transpose_item(a.in[9] + (size_t)li * DM * PW, DM, PW, Win_t, a.in[8] + li * DM, scr, it - I_OUT, lane);
    }
}

constexpr int H1_QT = 0, H1_KP = H1_QT + 4352, H1_KBT = H1_KP + 4352, H1_VT = H1_KBT + 5120, H1_DS = H1_VT + 5120, H1_BUF = H1_DS + 512, H1_TROW = 20;
__device__ __forceinline__ void hg_pass1(const Args& a, int layer, int unit, LAS unsigned char* lds) {
    int tid_ = threadIdx.x; asm volatile("" : "+v"(tid_)); const int tid = tid_, lane = tid & 63, wave = tid >> 6, l15 = lane & 15, quad = lane >> 4;
    const int b = unit / (HGH * NSC), h = (unit / NSC) % HGH, sc = unit % NSC;
    const int nsub = (sc == NSC - 1) ? 17 : 16;
    const int tg = quad, k = 16 * wave + l15;
    const bf16* P = (const bf16*)(a.ws + WS_P);
    const float lb = ((const float*)(a.ws + WS_LB))[layer * 512 + h * 128 + k];
    const size_t row0 = (size_t)b * LP + (size_t)sc * 256;
    float gacc = 0.f;
    f32x4 S[8];
#pragma unroll
    for (int kt = 0; kt < 8; ++kt) S[kt] = (f32x4){0.f, 0.f, 0.f, 0.f};
    unsigned short zn[4], qn[4], vn[4];
    { const bf16* pn = P + (row0 + 4 * tg) * PW + h * 128 + k;
#pragma unroll
      for (int e = 0; e < 4; ++e) { zn[e] = pn[e * PW + C_FH]; qn[e] = pn[e * PW + C_QH]; vn[e] = pn[e * PW + C_IH]; } }
    bf16* QH = (bf16*)(a.ws + WS_QH) + (row0 + 4 * tg) * 512 + h * 128 + k;
    for (int i = 0; i < nsub; ++i) {
        LAS unsigned char* buf = lds + (i & 1) * H1_BUF;
        float z[4], q[4]; unsigned short vr[4];
#pragma unroll
        for (int e = 0; e < 4; ++e) { z[e] = bf2f(zn[e]); q[e] = bf2f(qn[e]); vr[e] = vn[e]; }
        if (i + 1 < nsub) { const bf16* pn = P + (row0 + 16 * (i + 1) + 4 * tg) * PW + h * 128 + k;
#pragma unroll
            for (int e = 0; e < 4; ++e) { zn[e] = pn[e * PW + C_FH]; qn[e] = pn[e * PW + C_QH]; vn[e] = pn[e * PW + C_IH]; } }
        float c[4], kk[4], qs[4];
#pragma unroll
        for (int e = 0; e < 4; ++e) {
            const float sig = __builtin_amdgcn_rcpf(1.f + __expf(-z[e]));
            const float f = lb + (1.f - lb) * sig;
            c[e] = __logf(fmaxf(f, 1e-30f)); kk[e] = (1.f - lb) * (1.f - sig); qs[e] = silu_f(q[e]);
        }
        c[1] += c[0]; c[2] += c[1]; c[3] += c[2];
        const float T = c[3];
        float sincl = T, x = __shfl_up(sincl, 16);
        if (tg >= 1) sincl += x;
        x = __shfl_up(sincl, 32);
        if (tg >= 2) sincl += x;
        const float off = sincl - T, ce = __shfl(sincl, 48 + l15);
        float qt[4], kp[4], kb[4], qh[4];
        const float egacc = __expf(gacc);
#pragma unroll
        for (int e = 0; e < 4; ++e) {
            const float ct = off + c[e];
            qt[e] = qs[e] * __expf(ct); kp[e] = kk[e] * __expf(fminf(-ct, 80.f)); kb[e] = kk[e] * __expf(ce - ct); qh[e] = qt[e] * egacc;
        }
        const unsigned qt01 = pk2(qt[0], qt[1]), qt23 = pk2(qt[2], qt[3]), kp01 = pk2(kp[0], kp[1]), kp23 = pk2(kp[2], kp[3]), qh01 = pk2(qh[0], qh[1]), qh23 = pk2(qh[2], qh[3]);
        LAS unsigned short* qtp = (LAS unsigned short*)(buf + H1_QT) + (4 * tg) * 136 + k;
        qtp[0] = (unsigned short)qt01; qtp[136] = (unsigned short)(qt01 >> 16); qtp[272] = (unsigned short)qt23; qtp[408] = (unsigned short)(qt23 >> 16);
        LAS unsigned short* kpp = (LAS unsigned short*)(buf + H1_KP) + (4 * tg) * 136 + k;
        kpp[0] = (unsigned short)kp01; kpp[136] = (unsigned short)(kp01 >> 16); kpp[272] = (unsigned short)kp23; kpp[408] = (unsigned short)(kp23 >> 16);
        *(LAS u32x2*)(buf + H1_KBT + (k * H1_TROW + 4 * tg) * 2) = (u32x2){pk2(kb[0], kb[1]), pk2(kb[2], kb[3])};
        *(LAS u32x2*)(buf + H1_VT + (k * H1_TROW + 4 * tg) * 2) = (u32x2){(unsigned)vr[0] | ((unsigned)vr[1] << 16), (unsigned)vr[2] | ((unsigned)vr[3] << 16)};
        if (tg == 0) *(LAS float*)(buf + H1_DS + k * 4) = __expf(ce);
        if (i < 8) { LAS unsigned short* ql = (LAS unsigned short*)(lds + QLDS_OFF + (16 * i + 4 * tg) * QLDS_ROW) + k;
            ql[0] = (unsigned short)qh01; ql[QLDS_ROW / 2] = (unsigned short)(qh01 >> 16); ql[QLDS_ROW] = (unsigned short)qh23; ql[3 * QLDS_ROW / 2] = (unsigned short)(qh23 >> 16); }
        else
        { bf16* qo = QH + (size_t)(16 * i) * 512; qo[0] = (bf16)qh01; qo[512] = (bf16)(qh01 >> 16); qo[1024] = (bf16)qh23; qo[1536] = (bf16)(qh23 >> 16); }
        gacc += ce;
        __syncthreads();
        f32x4 at = {0.f, 0.f, 0.f, 0.f};
#pragma unroll
        for (int kq = 0; kq < 4; ++kq) {
            const s16x8 ka = *(const LAS s16x8*)(buf + H1_KP + (l15 * 136 + quad * 8 + 32 * kq) * 2);
            const s16x8 qb = *(const LAS s16x8*)(buf + H1_QT + (l15 * 136 + quad * 8 + 32 * kq) * 2);
            at = MFMA32(ka, qb, at);
        }
#pragma unroll
        for (int j = 0; j < 4; ++j) if (quad * 4 + j > l15) at[j] = 0.f;
        const u32x2 ptu = {pk2(at[0], at[1]), pk2(at[2], at[3])};
        const s16x4 pt = __builtin_bit_cast(s16x4, ptu);
        const s16x4 vf = *(const LAS s16x4*)(buf + H1_VT + ((16 * wave + l15) * H1_TROW + quad * 4) * 2);
        f32x4 o = {0.f, 0.f, 0.f, 0.f};
#pragma unroll
        for (int kq = 0; kq < 4; ++kq) {
            const u32x4 sau = {pk2(S[2 * kq][0], S[2 * kq][1]), pk2(S[2 * kq][2], S[2 * kq][3]), pk2(S[2 * kq + 1][0], S[2 * kq + 1][1]), pk2(S[2 * kq + 1][2], S[2 * kq + 1][3])};
            const s16x8 sa = __builtin_bit_cast(s16x8, sau);
            const u32x2 q0 = *(const LAS u32x2*)(buf + H1_QT + (l15 * 136 + 32 * kq + quad * 4) * 2);
            const u32x2 q1 = *(const LAS u32x2*)(buf + H1_QT + (l15 * 136 + 32 * kq + 16 + quad * 4) * 2);
            const u32x4 qbu = {q0.x, q0.y, q1.x, q1.y};
            o = MFMA32(sa, __builtin_bit_cast(s16x8, qbu), o);
        }
        MFMA_DRAIN();
        o = MFMA16(vf, pt, o);
        *(LAS u32x2*)(lds + OLDS_OFF + (16 * i + l15) * OLDS_ROW + (16 * wave + quad * 4) * 2) = (u32x2){pk2(o[0], o[1]), pk2(o[2], o[3])};
#pragma unroll
        for (int kt = 0; kt < 8; ++kt) {
            const f32x4 d = *(const LAS f32x4*)(buf + H1_DS + (16 * kt + quad * 4) * 4);
            const s16x4 ka = *(const LAS s16x4*)(buf + H1_KBT + ((16 * kt + l15) * H1_TROW + quad * 4) * 2);
            S[kt] = MFMA16(ka, vf, S[kt] * d);
        }
    }
    float* L = (float*)(a.ws + WS_L) + (size_t)((b * HGH + h) * NSC + sc) * 16384;
#pragma unroll
    for (int kt = 0; kt < 8; ++kt) *(f32x4*)(L + (16 * wave + l15) * 128 + 16 * kt + quad * 4) = S[kt];
    if (tg == 0) ((float*)(a.ws + WS_D))[((b * HGH + h) * NSC + sc) * 128 + k] = __expf(gacc);
    __syncthreads();
}

__device__ __forceinline__ void hg_scan(const Args& a, int layer) {
    const int G = gridDim.x;
    int tid_ = threadIdx.x; asm volatile("" : "+v"(tid_));
    for (int e = blockIdx.x * NTHREADS + tid_; e < NB * HGH * HK * HV; e += G * NTHREADS) {
        const int bh = e >> 14, kv = e & 16383, k = kv & 127, v = kv >> 7;
        const float* L = (const float*)(a.ws + WS_L) + (size_t)bh * NSC * 16384 + kv; const float* D = (const float*)(a.ws + WS_D) + bh * NSC * 128 + k;
        float l[NSC], d[NSC];
#pragma unroll
        for (int s = 0; s < NSC; ++s) { l[s] = __builtin_nontemporal_load(L + (size_t)s * 16384); d[s] = D[s * 128]; }
        float S = 0.f;
        bf16* Sst = (bf16*)(a.ws + WS_S) + (size_t)bh * NSC * 16384 + kv;
#pragma unroll
        for (int s = 0; s < NSC; ++s) { Sst[(size_t)s * 16384] = (bf16)pk2(S, S); S = d[s] * S + l[s]; }
        const int b = bh >> 2, h = bh & 3;
        a.out[O_HP + (size_t)((b * DEPTH + layer) * HGH + h) * 16384 + k * 128 + v] = S;
    }
}

__device__ __forceinline__ void hg_sample(const Args& a, int layer, int unit, LAS unsigned char* lds) {
    int tid_ = threadIdx.x; asm volatile("" : "+v"(tid_)); const int tid = tid_, lane = tid & 63, wave = tid >> 6;
    const int seq = unit >> 2, h = unit & 3;
    const int v4 = (tid & 31) * 4, kg = tid >> 5;
    const bf16* prow = (const bf16*)(a.ws + WS_P) + (size_t)(MP + seq) * PW + h * 128;
    const float* lbp = (const float*)(a.ws + WS_LB) + layer * 512 + h * 128 + kg * 8;
    const u32x4 zz = *(const u32x4*)(prow + C_FH + kg * 8), qq = *(const u32x4*)(prow + C_QH + kg * 8);
    const u32x2 vv = *(const u32x2*)(prow + C_IH + v4);
    const float z[8] = {bflo(zz.x), bfhi(zz.x), bflo(zz.y), bfhi(zz.y), bflo(zz.z), bfhi(zz.z), bflo(zz.w), bfhi(zz.w)};
    const float q[8] = {bflo(qq.x), bfhi(qq.x), bflo(qq.y), bfhi(qq.y), bflo(qq.z), bfhi(qq.z), bflo(qq.w), bfhi(qq.w)};
    const f32x4 v = {bflo(vv.x), bfhi(vv.x), bflo(vv.y), bfhi(vv.y)};
    const size_t sidx = (size_t)((seq * DEPTH + layer) * HGH + h) * 16384;
    const float* S0 = a.in[6] + sidx; float* S1 = a.out + O_HS + sidx;
    f32x4 o = {0.f, 0.f, 0.f, 0.f};
#pragma unroll
    for (int i = 0; i < 8; ++i) {
        const float lbv = lbp[i];
        const float sig = 1.f / (1.f + __expf(-z[i])), sigm = 1.f / (1.f + __expf(z[i]));
        const float f = fmaxf(lbv + (1.f - lbv) * sig, 1e-30f), kk = (1.f - lbv) * sigm, qs = silu_f(q[i]);
        const int k = kg * 8 + i;
        const f32x4 s0 = __builtin_nontemporal_load((const f32x4*)(S0 + k * 128 + v4));
        const f32x4 s1 = s0 * f + v * kk;
        __builtin_nontemporal_store(s1, (f32x4*)(S1 + k * 128 + v4));
        o += s1 * qs;
    }
    LAS float* red = (LAS float*)lds;
    LAS float* red2 = (LAS float*)(lds + 8192);
    *(LAS f32x4*)(red + kg * 128 + v4) = o;
    __syncthreads();
    float ov = 0.f;
    if (tid < 128) {
#pragma unroll
        for (int g = 0; g < 16; ++g) ov += red[g * 128 + tid];
        const float ssq = wave_sum(ov * ov);
        if (lane == 0) red2[wave] = ssq;
    }
    __syncthreads();
    if (tid < 128) {
        const float rs = rsqrtf((red2[0] + red2[1]) * (1.f / HV) + EPS);
        const float gh = bf2f(prow[C_GH + tid]);
        bf16* MIX = (bf16*)(a.ws + WS_MIX);
        MIX[(size_t)(MP + seq) * DM + 512 + h * 128 + tid] = (bf16)f2bf(ov * rs * a.in[14][layer * HV + tid] * silu_f(gh));
    }
    __syncthreads();
}


__device__ __forceinline__ void hg_sample2(const Args& a, int layer, int u0, int u1, LAS unsigned char* lds) {
    int tid_ = threadIdx.x; asm volatile("" : "+v"(tid_)); const int tid = tid_, lane = tid & 63, wave = tid >> 6;
    const int v4 = (tid & 31) * 4, kg = tid >> 5;
    const int uu[2] = {u0, u1};
    u32x4 zz[2], qq[2]; u32x2 vv[2]; f32x4 s0[2][8]; float lbv[8];
    const bf16* prow[2]; const float* S0p[2]; float* S1p[2];
#pragma unroll
    for (int t = 0; t < 2; ++t) {
        const int seq = uu[t] >> 2, h = uu[t] & 3;
        prow[t] = (const bf16*)(a.ws + WS_P) + (size_t)(MP + seq) * PW + h * 128;
        zz[t] = *(const u32x4*)(prow[t] + C_FH + kg * 8); qq[t] = *(const u32x4*)(prow[t] + C_QH + kg * 8); vv[t] = *(const u32x2*)(prow[t] + C_IH + v4);
        const size_t sidx = (size_t)((seq * DEPTH + layer) * HGH + h) * 16384;
        S0p[t] = a.in[6] + sidx; S1p[t] = a.out + O_HS + sidx;
#pragma unroll
        for (int i = 0; i < 8; ++i) s0[t][i] = __builtin_nontemporal_load((const f32x4*)(S0p[t] + (kg * 8 + i) * 128 + v4));
    }
    LAS float* red = (LAS float*)lds;
    LAS float* red2 = (LAS float*)(lds + 16384);
#pragma unroll
    for (int t = 0; t < 2; ++t) {
        const int h = uu[t] & 3;
        const float* lbp = (const float*)(a.ws + WS_LB) + layer * 512 + h * 128 + kg * 8;
        const float z[8] = {bflo(zz[t].x), bfhi(zz[t].x), bflo(zz[t].y), bfhi(zz[t].y), bflo(zz[t].z), bfhi(zz[t].z), bflo(zz[t].w), bfhi(zz[t].w)};
        const float q[8] = {bflo(qq[t].x), bfhi(qq[t].x), bflo(qq[t].y), bfhi(qq[t].y), bflo(qq[t].z), bfhi(qq[t].z), bflo(qq[t].w), bfhi(qq[t].w)};
        const f32x4 v = {bflo(vv[t].x), bfhi(vv[t].x), bflo(vv[t].y), bfhi(vv[t].y)};
        f32x4 o = {0.f, 0.f, 0.f, 0.f};
#pragma unroll
        for (int i = 0; i < 8; ++i) {
            const float lb1 = lbp[i];
            const float sig = 1.f / (1.f + __expf(-z[i])), sigm = 1.f / (1.f + __expf(z[i]));
            const float f = fmaxf(lb1 + (1.f - lb1) * sig, 1e-30f), kk = (1.f - lb1) * sigm, qs = silu_f(q[i]);
            const f32x4 s1 = s0[t][i] * f + v * kk;
            __builtin_nontemporal_store(s1, (f32x4*)(S1p[t] + (kg * 8 + i) * 128 + v4));
            o += s1 * qs;
        }
        *(LAS f32x4*)(red + t * 2048 + kg * 128 + v4) = o;
    }
    __syncthreads();
    float ov = 0.f; const int t2 = tid >> 7, vi = tid & 127;
    if (tid < 256) {
#pragma unroll
        for (int g = 0; g < 16; ++g) ov += red[t2 * 2048 + g * 128 + vi];
        const float ssq = wave_sum(ov * ov);
        if (lane == 0) red2[wave] = ssq;
    }
    __syncthreads();
    if (tid < 256) {
        const int seq = uu[t2] >> 2, h = uu[t2] & 3;
        const float rs = rsqrtf((red2[2 * t2] + red2[2 * t2 + 1]) * (1.f / HV) + EPS);
        const float gh = bf2f(prow[t2][C_GH + vi]);
        bf16* MIX = (bf16*)(a.ws + WS_MIX);
        MIX[(size_t)(MP + seq) * DM + 512 + h * 128 + vi] = (bf16)f2bf(ov * rs * a.in[14][layer * HV + vi] * silu_f(gh));
    }
    __syncthreads();
}
struct P2Tile { s16x8 bq[4]; u32x2 ggv[8]; };
__device__ __forceinline__ void p2_load(P2Tile& T, const bf16* P, const bf16* QH, const bf16* OL, size_t row, int h, int quad, LAS unsigned char* qlds = nullptr, int lrow = 0) {
    const bf16* prow = P + row * PW + h * 128;
    if (qlds) {
#pragma unroll
        for (int kq = 0; kq < 4; ++kq) T.bq[kq] = *(const LAS s16x8*)(qlds + lrow * QLDS_ROW + (quad * 8 + 32 * kq) * 2);
    } else
#pragma unroll
    for (int kq = 0; kq < 4; ++kq) T.bq[kq] = __builtin_nontemporal_load((const s16x8*)(QH + row * 512 + h * 128 + quad * 8 + 32 * kq));
#pragma unroll
    for (int vt = 0; vt < 8; ++vt) {
        T.ggv[vt] = *(const u32x2*)(prow + C_GH + 16 * vt + quad * 4); }
}
__device__ __forceinline__ void p2_compute(const P2Tile& T, const Args& a, int layer, bf16* MIX, LAS unsigned char* lds, size_t row, int lrow, int h, int l15, int quad) {
    f32x4 o[8]; float ssq = 0.f;
#pragma unroll
    for (int vt = 0; vt < 8; ++vt) {
        f32x4 acc = {0.f, 0.f, 0.f, 0.f};
#pragma unroll
        for (int kq = 0; kq < 4; ++kq) { const s16x8 sa = *(const LAS s16x8*)(lds + ((16 * vt + l15) * 136 + quad * 8 + 32 * kq) * 2); acc = MFMA32(sa, T.bq[kq], acc); }
        const u32x2 ol = *(const LAS u32x2*)(lds + OLDS_OFF + lrow * OLDS_ROW + (16 * vt + quad * 4) * 2);
        acc += (f32x4){bflo(ol.x), bfhi(ol.x), bflo(ol.y), bfhi(ol.y)};
        o[vt] = acc; ssq += acc[0] * acc[0] + acc[1] * acc[1] + acc[2] * acc[2] + acc[3] * acc[3];
        if ((vt & 3) == 3) __builtin_amdgcn_sched_barrier(0);
    }
    ssq += __shfl_xor(ssq, 16); ssq += __shfl_xor(ssq, 32);
    const float rs = rsqrtf(ssq * (1.f / HV) + EPS);
#pragma unroll
    for (int vt = 0; vt < 8; ++vt) {
        const u32x2 gg = T.ggv[vt];
        const f32x4 w = *(const f32x4*)(a.in[14] + layer * HV + 16 * vt + quad * 4);
        const float r0 = o[vt][0] * rs * w[0] * silu_f(bflo(gg.x)), r1 = o[vt][1] * rs * w[1] * silu_f(bfhi(gg.x)), r2 = o[vt][2] * rs * w[2] * silu_f(bflo(gg.y)), r3 = o[vt][3] * rs * w[3] * silu_f(bfhi(gg.y));
        *(u32x2*)(MIX + row * DM + 512 + h * 128 + 16 * vt + quad * 4) = (u32x2){pk2(r0, r1), pk2(r2, r3)};
    }
}
__device__ __forceinline__ void hg_pass2(const Args& a, int layer, int unit, LAS unsigned char* lds) {
    int tid_ = threadIdx.x; asm volatile("" : "+v"(tid_)); const int tid = tid_, lane = tid & 63, wave = tid >> 6, l15 = lane & 15, quad = lane >> 4;
    const int b = unit / (HGH * NSC), h = (unit / NSC) % HGH, sc = unit % NSC;
    const int nsub = (sc == NSC - 1) ? 17 : 16;
    const size_t row0 = (size_t)b * LP + (size_t)sc * 256;
    const bf16* P = (const bf16*)(a.ws + WS_P); bf16* MIX = (bf16*)(a.ws + WS_MIX);
    const bf16* Sst = (const bf16*)(a.ws + WS_S) + (size_t)((b * HGH + h) * NSC + sc) * 16384;
    const bf16* QH = (const bf16*)(a.ws + WS_QH); const bf16* OL = (const bf16*)(a.ws + WS_OL);
    u32x4 sv[4];
#pragma unroll
    for (int j = 0; j < 4; ++j) { const int idx = tid + NTHREADS * j, v = idx >> 4, k8 = (idx & 15) * 8; sv[j] = __builtin_nontemporal_load((const u32x4*)(Sst + v * 128 + k8)); }
    const size_t rowA = row0 + 16 * wave + l15, rowB = rowA + 128;
    P2Tile TA, TB;
    p2_load(TA, P, QH, OL, rowA, h, quad, lds + QLDS_OFF, 16 * wave + l15);
    p2_load(TB, P, QH, OL, rowB, h, quad);
#pragma unroll
    for (int j = 0; j < 4; ++j) { const int idx = tid + NTHREADS * j, v = idx >> 4, k8 = (idx & 15) * 8;
        *(LAS u32x4*)(lds + (v * 136 + k8) * 2) = sv[j]; }
    __syncthreads();
    p2_compute(TA, a, layer, MIX, lds, rowA, 16 * wave + l15, h, l15, quad);
    p2_compute(TB, a, layer, MIX, lds, rowB, 16 * wave + l15 + 128, h, l15, quad);
    if (wave + 16 < nsub) {
        const size_t rowC = rowA + 256;
        p2_load(TA, P, QH, OL, rowC, h, quad);
        p2_compute(TA, a, layer, MIX, lds, rowC, 16 * wave + l15 + 256, h, l15, quad);
    }
    __syncthreads();
}

constexpr int PA_KROW = 72, PA_V = 272 * PA_KROW * 2, PA_VROW = 280;
constexpr int PA_VR = 160;
__device__ __forceinline__ void pattn(const Args& a, int layer, int unit, LAS unsigned char* lds) {
    int tid_ = threadIdx.x; asm volatile("" : "+v"(tid_)); const int tid = tid_, lane = tid & 63, wave = tid >> 6, l15 = lane & 15, quad = lane >> 4;
    int b, nb; const int kvh = unit & 1;
    if (unit < 256) { b = unit >> 7; nb = (unit >> 1) & 63; } else { b = (unit - 256) >> 1; nb = 64; }
    const bf16* P = (const bf16*)(a.ws + WS_P); bf16* MIX = (bf16*)(a.ws + WS_MIX);
    const float* knw = a.in[11] + layer * HD; const float* qnw = a.in[10] + layer * HD;
    u32x4 kxa[5], vxa[5];
#pragma unroll
    for (int j = 0; j < 5; ++j) {
        const int it = tid + NTHREADS * j, kr = it >> 3, c8 = it & 7;
        const int pos = kr < 16 ? kr : (nb - 1) * 128 + (kr - 16);
        const bool valid = (kr < 272) && pos >= 0 && pos < LP;
        const size_t row = (size_t)b * LP + pos;
        kxa[j] = (u32x4){0u, 0u, 0u, 0u}; vxa[j] = (u32x4){0u, 0u, 0u, 0u};
        if (valid) { kxa[j] = *(const u32x4*)(P + row * PW + C_KA + kvh * 64 + c8 * 8); vxa[j] = *(const u32x4*)(P + row * PW + C_VA + kvh * 64 + c8 * 8); }
    }
    u32x4 qn0 = {0u, 0u, 0u, 0u}, qn1 = {0u, 0u, 0u, 0u};
    { const int qt = wave * 4, g = qt >> 3, r0 = (qt & 7) * 16, p = nb * 128 + r0 + l15;
      if (p < LP) { const bf16* qp = P + ((size_t)b * LP + p) * PW + C_QA + (kvh * 4 + g) * 64 + quad * 8; qn0 = *(const u32x4*)qp; qn1 = *(const u32x4*)(qp + 32); } }
#pragma unroll
    for (int j = 0; j < 5; ++j) {
        const int it = tid + NTHREADS * j, kr = it >> 3, c8 = it & 7;
        const int pos = kr < 16 ? kr : (nb - 1) * 128 + (kr - 16);
        const bool valid = (kr < 272) && pos >= 0 && pos < LP;
        const u32x4 kx = kxa[j], vx = vxa[j];
        float kf[8] = {bflo(kx.x), bfhi(kx.x), bflo(kx.y), bfhi(kx.y), bflo(kx.z), bfhi(kx.z), bflo(kx.w), bfhi(kx.w)};
        float ssq = 0.f;
#pragma unroll
        for (int e = 0; e < 8; ++e) ssq += kf[e] * kf[e];
        ssq += __shfl_xor(ssq, 1); ssq += __shfl_xor(ssq, 2); ssq += __shfl_xor(ssq, 4);
        const float rs = rsqrtf(ssq * (1.f / HD) + EPS);
        const f32x4 w0 = *(const f32x4*)(knw + c8 * 8), w1 = *(const f32x4*)(knw + c8 * 8 + 4);
        kf[0] *= rs * w0[0]; kf[1] *= rs * w0[1]; kf[2] *= rs * w0[2]; kf[3] *= rs * w0[3]; kf[4] *= rs * w1[0]; kf[5] *= rs * w1[1]; kf[6] *= rs * w1[2]; kf[7] *= rs * w1[3];
        if (kr < 272) {
            *(LAS u32x4*)(lds + (kr * PA_KROW + c8 * 8) * 2) = (u32x4){pk2(kf[0], kf[1]), pk2(kf[2], kf[3]), pk2(kf[4], kf[5]), pk2(kf[6], kf[7])};
            *(LAS u32x4*)(lds + PA_V + kr * PA_VR + c8 * 16) = vx;
        }
        if (valid) {
            float* ok = nullptr; float* ov = nullptr;
            if (nb == 0 && kr < 16) { const size_t o = ((size_t)((b * DEPTH + layer) * NMETA + kr) * NKV + kvh) * HD + c8 * 8; ok = a.out + O_MKP + o; ov = a.out + O_MVP + o; }
            else if (kr >= 144 && pos >= LP - WIN) { const size_t o = ((size_t)((b * DEPTH + layer) * WIN + (pos - (LP - WIN))) * NKV + kvh) * HD + c8 * 8; ok = a.out + O_WKP + o; ov = a.out + O_WVP + o; }
            if (ok) {
                *(f32x4*)ok = (f32x4){kf[0], kf[1], kf[2], kf[3]}; *(f32x4*)(ok + 4) = (f32x4){kf[4], kf[5], kf[6], kf[7]};
                *(f32x4*)ov = (f32x4){bflo(vx.x), bfhi(vx.x), bflo(vx.y), bfhi(vx.y)}; *(f32x4*)(ov + 4) = (f32x4){bflo(vx.z), bfhi(vx.z), bflo(vx.w), bfhi(vx.w)};
            }
        }
    }
    __syncthreads();
    const int nq = (nb == 64) ? 1 : 8;
#pragma unroll 1
    for (int i = 0; i < 4; ++i) {
        const int qt = wave * 4 + i, g = qt >> 3, tb = qt & 7, r0 = tb * 16, head = kvh * 4 + g;
        const int p = nb * 128 + r0 + l15; const bool qvalid = p < LP; const size_t row = (size_t)b * LP + p;
        const u32x4 qx0 = qn0, qx1 = qn1;
        if (i < 3) {
            const int qt2 = qt + 1, g2 = qt2 >> 3, p2 = nb * 128 + (qt2 & 7) * 16 + l15;
            qn0 = (u32x4){0u, 0u, 0u, 0u}; qn1 = (u32x4){0u, 0u, 0u, 0u};
            if (p2 < LP) { const bf16* qp = P + ((size_t)b * LP + p2) * PW + C_QA + (kvh * 4 + g2) * 64 + quad * 8; qn0 = *(const u32x4*)qp; qn1 = *(const u32x4*)(qp + 32); }
        }
        if (tb >= nq) continue;
        u32x2 gg[4];
#pragma unroll
        for (int dt = 0; dt < 4; ++dt) { gg[dt] = (u32x2){0u, 0u}; if (qvalid) gg[dt] = *(const u32x2*)(P + row * PW + C_GA + head * 64 + 16 * dt + quad * 4); }
        const float sink = a.in[12][layer * NQH + head] * 1.4426950408889634f;
        float qf[16] = {bflo(qx0.x), bfhi(qx0.x), bflo(qx0.y), bfhi(qx0.y), bflo(qx0.z), bfhi(qx0.z), bflo(qx0.w), bfhi(qx0.w),
                        bflo(qx1.x), bfhi(qx1.x), bflo(qx1.y), bfhi(qx1.y), bflo(qx1.z), bfhi(qx1.z), bflo(qx1.w), bfhi(qx1.w)};
        float ssq = 0.f;
#pragma unroll
        for (int e = 0; e < 16; ++e) ssq += qf[e] * qf[e];
        ssq += __shfl_xor(ssq, 16); ssq += __shfl_xor(ssq, 32);
        const float rs = rsqrtf(ssq * (1.f / HD) + EPS) * (0.125f * 1.4426950408889634f);
        s16x8 bq[2];
#pragma unroll
        for (int kq = 0; kq < 2; ++kq) {
            const f32x4 w0 = *(const f32x4*)(qnw + quad * 8 + 32 * kq), w1 = *(const f32x4*)(qnw + quad * 8 + 32 * kq + 4);
            const u32x4 pk = {pk2(qf[kq * 8 + 0] * rs * w0[0], qf[kq * 8 + 1] * rs * w0[1]), pk2(qf[kq * 8 + 2] * rs * w0[2], qf[kq * 8 + 3] * rs * w0[3]),
                              pk2(qf[kq * 8 + 4] * rs * w1[0], qf[kq * 8 + 5] * rs * w1[1]), pk2(qf[kq * 8 + 6] * rs * w1[2], qf[kq * 8 + 7] * rs * w1[3])};
            bq[kq] = __builtin_bit_cast(s16x8, pk);
        }
        LAS unsigned char* kb0 = lds + (l15 * PA_KROW + quad * 8) * 2;
        LAS unsigned char* kbt = kb0 + tb * (16 * PA_KROW * 2);
        f32x4 at[10];
#pragma unroll
        for (int r = 0; r < 10; ++r) {
            f32x4 acc = {0.f, 0.f, 0.f, 0.f};
            LAS unsigned char* kp = (r == 0) ? kb0 : kbt + r * (16 * PA_KROW * 2);
#pragma unroll
            for (int kq = 0; kq < 2; ++kq) { const s16x8 ka = *(const LAS s16x8*)(kp + kq * 64); acc = MFMA32(ka, bq[kq], acc); }
            at[r] = acc;
        }
        const int lo_b = 32 - (nb - 1) * 128 - 16 * tb;
        const int lor = ((l15 + 17 > lo_b) ? l15 + 17 : lo_b) - quad * 4, hir = 144 + l15 - quad * 4, pmr = (p < 15 ? p : 15) - quad * 4;
        float mx = -1e30f;
#pragma unroll
        for (int r = 0; r < 10; ++r) {
            if (r >= 2 && r <= 8 && nb >= 1) {
#pragma unroll
                for (int j = 0; j < 4; ++j) mx = fmaxf(mx, at[r][j]);
            } else {
#pragma unroll
                for (int j = 0; j < 4; ++j) {
                    const int c = 16 * r + j;
                    const bool vis = (r == 0) ? (c <= pmr) : (c >= lor && c <= hir);
                    const float s = vis ? at[r][j] : -1e30f; at[r][j] = s; mx = fmaxf(mx, s);
                }
            }
        }
        mx = fmaxf(mx, __shfl_xor(mx, 16)); mx = fmaxf(mx, __shfl_xor(mx, 32));
        const float m = fmaxf(mx, sink);
        float sum = 0.f;
#pragma unroll
        for (int r = 0; r < 10; ++r) {
#pragma unroll
            for (int j = 0; j < 4; ++j) { const float e = __builtin_amdgcn_exp2f(at[r][j] - m); at[r][j] = e; sum += e; }
        }
        sum += __shfl_xor(sum, 16); sum += __shfl_xor(sum, 32);
        const float inv = 1.f / (sum + __builtin_amdgcn_exp2f(sink - m));
        f32x4 ot[4];
#pragma unroll
        for (int dt = 0; dt < 4; ++dt) ot[dt] = (f32x4){0.f, 0.f, 0.f, 0.f};
        LAS unsigned char* vb0 = lds + PA_V + (quad * 4 + (l15 >> 2)) * PA_VR + (l15 & 3) * 8;
        LAS unsigned char* vbt = vb0 + tb * (16 * PA_VR);
#pragma unroll
        for (int r = 0; r < 10; ++r) {
            const u32x2 pp = {pk2(at[r][0], at[r][1]), pk2(at[r][2], at[r][3])};
            const s16x4 pt = __builtin_bit_cast(s16x4, pp);
            LAS unsigned char* vp = (r == 0) ? vb0 : vbt + r * (16 * PA_VR);
#pragma unroll
            for (int dt = 0; dt < 4; ++dt) { const s16x4 va = __builtin_amdgcn_ds_read_tr16_b64_v4i16((LAS s16x4*)(vp + dt * 32)); ot[dt] = MFMA16(va, pt, ot[dt]); }
        }
        if (qvalid) {
#pragma unroll
            for (int dt = 0; dt < 4; ++dt) {
                const int d = 16 * dt + quad * 4;
                const float r0v = ot[dt][0] * inv * silu_f(bflo(gg[dt].x)), r1v = ot[dt][1] * inv * silu_f(bfhi(gg[dt].x)), r2v = ot[dt][2] * inv * silu_f(bflo(gg[dt].y)), r3v = ot[dt][3] * inv * silu_f(bfhi(gg[dt].y));
                *(u32x2*)(MIX + row * DM + head * 64 + d) = (u32x2){pk2(r0v, r1v), pk2(r2v, r3v)};
            }
        }
    }
    __syncthreads();
}

constexpr int SA_ROW = 136, SA_K = 0, SA_V = 39936, SA_Q = 79872, SA_P = 81920;
__device__ __forceinline__ void sattn(const Args& a, int layer, int seq, LAS unsigned char* lds) {
    int tid_ = threadIdx.x; asm volatile("" : "+v"(tid_)); const int tid = tid_, lane = tid & 63, wave = tid >> 6;
    const size_t cidx = (size_t)(seq * DEPTH + layer) * WIN * 128, midx = (size_t)(seq * DEPTH + layer) * NMETA * 128;
    const float* ck = a.in[2] + cidx; const float* cv = a.in[3] + cidx; const float* mk = a.in[4] + midx; const float* mv = a.in[5] + midx;
    float* ok = a.out + O_WKS + cidx; float* ov = a.out + O_WVS + cidx;
    const size_t row = MP + seq;
    const bf16* prow = (const bf16*)(a.ws + WS_P) + row * PW;
#pragma unroll
    for (int j = 0; j < 8; ++j) {
        const int idx = tid + NTHREADS * j, r = idx >> 5, c4 = (idx & 31) * 4;
        const f32x4 kx = *(const f32x4*)(ck + r * 128 + c4), vx = *(const f32x4*)(cv + r * 128 + c4);
        if (r >= 1) { *(f32x4*)(ok + (r - 1) * 128 + c4) = kx; *(f32x4*)(ov + (r - 1) * 128 + c4) = vx; }
        *(LAS u32x2*)(lds + SA_K + ((16 + r) * SA_ROW + c4) * 2) = (u32x2){pk2(kx[0], kx[1]), pk2(kx[2], kx[3])};
        *(LAS u32x2*)(lds + SA_V + ((16 + r) * SA_ROW + c4) * 2) = (u32x2){pk2(vx[0], vx[1]), pk2(vx[2], vx[3])};
    }
    { const int r = tid >> 5, c4 = (tid & 31) * 4;
      const f32x4 kx = *(const f32x4*)(mk + r * 128 + c4), vx = *(const f32x4*)(mv + r * 128 + c4);
      *(LAS u32x2*)(lds + SA_K + (r * SA_ROW + c4) * 2) = (u32x2){pk2(kx[0], kx[1]), pk2(kx[2], kx[3])};
      *(LAS u32x2*)(lds + SA_V + (r * SA_ROW + c4) * 2) = (u32x2){pk2(vx[0], vx[1]), pk2(vx[2], vx[3])}; }
    if (wave == 0) {
        const int kvh = lane >> 5, d2 = (lane & 31) * 2;
        const unsigned kk2 = *(const unsigned*)(prow + C_KA + kvh * 64 + d2);
        const float k0 = bflo(kk2), k1 = bfhi(kk2);
        float ssq = k0 * k0 + k1 * k1;
#pragma unroll
        for (int o = 1; o < 32; o <<= 1) ssq += __shfl_xor(ssq, o);
        const float rs = rsqrtf(ssq * (1.f / HD) + EPS);
        const float n0 = k0 * rs * a.in[11][layer * HD + d2], n1 = k1 * rs * a.in[11][layer * HD + d2 + 1];
        ok[127 * 128 + kvh * 64 + d2] = n0; ok[127 * 128 + kvh * 64 + d2 + 1] = n1;
        *(LAS unsigned*)(lds + SA_K + (144 * SA_ROW + kvh * 64 + d2) * 2) = pk2(n0, n1);
    } else if (wave == 1) {
        const int kvh = lane >> 5, d2 = (lane & 31) * 2;
        const unsigned vv2 = *(const unsigned*)(prow + C_VA + kvh * 64 + d2);
        ov[127 * 128 + kvh * 64 + d2] = bflo(vv2); ov[127 * 128 + kvh * 64 + d2 + 1] = bfhi(vv2);
        *(LAS unsigned*)(lds + SA_V + (144 * SA_ROW + kvh * 64 + d2) * 2) = vv2;
    }
    LAS float* Qs = (LAS float*)(lds + SA_Q) + wave * 64; LAS float* Ps = (LAS float*)(lds + SA_P) + wave * 160;
    { const float q = bf2f(prow[C_QA + wave * 64 + lane]); const float ssq = wave_sum(q * q);
      Qs[lane] = q * rsqrtf(ssq * (1.f / HD) + EPS) * a.in[10][layer * HD + lane] * 0.125f; }
    __syncthreads();
    const int kvh = wave >> 2; const float sink = a.in[12][layer * NQH + wave];
    float scv[3]; float mx = -1e30f;
#pragma unroll
    for (int r3 = 0; r3 < 3; ++r3) {
        const int j = lane + 64 * r3; float s = -1e30f;
        if (j < 145 && j != 16) {
            float acc = 0.f;
#pragma unroll
            for (int c = 0; c < 8; ++c) { const u32x4 kx = *(const LAS u32x4*)(lds + SA_K + (j * SA_ROW + kvh * 64 + c * 8) * 2);
                const LAS float* qp = Qs + c * 8;
                acc += qp[0] * bflo(kx.x) + qp[1] * bfhi(kx.x) + qp[2] * bflo(kx.y) + qp[3] * bfhi(kx.y) + qp[4] * bflo(kx.z) + qp[5] * bfhi(kx.z) + qp[6] * bflo(kx.w) + qp[7] * bfhi(kx.w); }
            s = acc;
        }
        scv[r3] = s; mx = fmaxf(mx, s);
    }
    mx = wave_max(mx);
    const float m = fmaxf(mx, sink);
    float sum = 0.f;
#pragma unroll
    for (int r3 = 0; r3 < 3; ++r3) { scv[r3] = __expf(scv[r3] - m); sum += scv[r3]; }
    sum = wave_sum(sum);
    const float inv = 1.f / (sum + __expf(sink - m));
#pragma unroll
    for (int r3 = 0; r3 < 3; ++r3) { const int j = lane + 64 * r3; if (j < 160) Ps[j] = scv[r3] * inv; }
    __syncthreads();
    float o = 0.f;
#pragma unroll 5
    for (int j = 0; j < 145; ++j) o += Ps[j] * bf2f(*(const LAS unsigned short*)(lds + SA_V + (j * SA_ROW + kvh * 64 + lane) * 2));
    const float ga = bf2f(prow[C_GA + wave * 64 + lane]);
    ((bf16*)(a.ws + WS_MIX))[row * DM + wave * 64 + lane] = (bf16)f2bf(o * silu_f(ga));
    __syncthreads();
}


constexpr int S2_ROW = 72, S2_K = 0, S2_V = 145 * S2_ROW * 2  , S2_Q = 41984, S2_P = S2_Q + 4 * 64 * 4  , S2_ST = S2_P + 4 * 160 * 4  , S2_O = S2_ST + 64  ;
__device__ __forceinline__ void sattn2(const Args& a, int layer, int unit, LAS unsigned char* lds) {
    int tid_ = threadIdx.x; asm volatile("" : "+v"(tid_)); const int tid = tid_, lane = tid & 63, wave = tid >> 6;
    const int seq = unit >> 1, kvh = unit & 1;
    const size_t cidx = (size_t)(seq * DEPTH + layer) * WIN * 128 + kvh * 64, midx = (size_t)(seq * DEPTH + layer) * NMETA * 128 + kvh * 64;
    const float* ck = a.in[2] + cidx; const float* cv = a.in[3] + cidx; const float* mk = a.in[4] + midx; const float* mv = a.in[5] + midx;
    float* ok = a.out + O_WKS + cidx; float* ov = a.out + O_WVS + cidx;
    const size_t row = MP + seq;
    const bf16* prow = (const bf16*)(a.ws + WS_P) + row * PW;
#pragma unroll
    for (int j = 0; j < 4; ++j) {
        const int idx = tid + NTHREADS * j, r = idx >> 4, c4 = (idx & 15) * 4;
        const f32x4 kx = __builtin_nontemporal_load((const f32x4*)(ck + r * 128 + c4)), vx = __builtin_nontemporal_load((const f32x4*)(cv + r * 128 + c4));
        if (r >= 1) { __builtin_nontemporal_store(kx, (f32x4*)(ok + (r - 1) * 128 + c4)); __builtin_nontemporal_store(vx, (f32x4*)(ov + (r - 1) * 128 + c4)); }
        *(LAS u32x2*)(lds + S2_K + ((16 + r) * S2_ROW + c4) * 2) = (u32x2){pk2(kx[0], kx[1]), pk2(kx[2], kx[3])};
        *(LAS u32x2*)(lds + S2_V + ((16 + r) * S2_ROW + c4) * 2) = (u32x2){pk2(vx[0], vx[1]), pk2(vx[2], vx[3])};
    }
    if (tid < 256) { const int r = tid >> 4, c4 = (tid & 15) * 4;
      const f32x4 kx = *(const f32x4*)(mk + r * 128 + c4), vx = *(const f32x4*)(mv + r * 128 + c4);
      *(LAS u32x2*)(lds + S2_K + (r * S2_ROW + c4) * 2) = (u32x2){pk2(kx[0], kx[1]), pk2(kx[2], kx[3])};
      *(LAS u32x2*)(lds + S2_V + (r * S2_ROW + c4) * 2) = (u32x2){pk2(vx[0], vx[1]), pk2(vx[2], vx[3])}; }
    if (wave == 4) {
        const int d2 = (lane & 31) * 2;
        const unsigned kk2 = *(const unsigned*)(prow + C_KA + kvh * 64 + d2);
        const float k0 = bflo(kk2), k1 = bfhi(kk2);
        float ssq = k0 * k0 + k1 * k1;
#pragma unroll
        for (int o = 1; o < 32; o <<= 1) ssq += __shfl_xor(ssq, o);
        const float rs = rsqrtf(ssq * (1.f / HD) + EPS);
        const float n0 = k0 * rs * a.in[11][layer * HD + d2], n1 = k1 * rs * a.in[11][layer * HD + d2 + 1];
        if (lane < 32) { ok[127 * 128 + d2] = n0; ok[127 * 128 + d2 + 1] = n1; *(LAS unsigned*)(lds + S2_K + (144 * S2_ROW + d2) * 2) = pk2(n0, n1); }
    } else if (wave == 5) {
        if (lane < 32) { const int d2 = lane * 2; const unsigned vv2 = *(const unsigned*)(prow + C_VA + kvh * 64 + d2);
            ov[127 * 128 + d2] = bflo(vv2); ov[127 * 128 + d2 + 1] = bfhi(vv2); *(LAS unsigned*)(lds + S2_V + (144 * S2_ROW + d2) * 2) = vv2; }
    }
    const int g = wave & 3, hf = wave >> 2, head = kvh * 4 + g;
    LAS float* Qs = (LAS float*)(lds + S2_Q) + g * 64; LAS float* Ps = (LAS float*)(lds + S2_P) + g * 160;
    LAS float* St = (LAS float*)(lds + S2_ST);
    LAS float* Op = (LAS float*)(lds + S2_O);
    if (hf == 0) { const float q = bf2f(prow[C_QA + head * 64 + lane]); const float ssq = wave_sum(q * q);
      Qs[lane] = q * rsqrtf(ssq * (1.f / HD) + EPS) * a.in[10][layer * HD + lane] * 0.125f; }
    __syncthreads();
    const float sink = a.in[12][layer * NQH + head];
    float scv[2]; float mx = -1e30f;
#pragma unroll
    for (int r2 = 0; r2 < 2; ++r2) {
        const int j = (hf == 0) ? lane + 128 * r2 : (r2 == 0 ? 64 + lane : 1000);
        float sc = -1e30f;
        if (j < 145 && j != 16) {
            float acc = 0.f;
#pragma unroll
            for (int c = 0; c < 8; ++c) { const u32x4 kx = *(const LAS u32x4*)(lds + S2_K + (j * S2_ROW + c * 8) * 2);
                const LAS float* qp = Qs + c * 8;
                acc += qp[0] * bflo(kx.x) + qp[1] * bfhi(kx.x) + qp[2] * bflo(kx.y) + qp[3] * bfhi(kx.y) + qp[4] * bflo(kx.z) + qp[5] * bfhi(kx.z) + qp[6] * bflo(kx.w) + qp[7] * bfhi(kx.w); }
            sc = acc;
        }
        scv[r2] = sc; mx = fmaxf(mx, sc);
    }
    mx = wave_max(mx);
    float sum = 0.f;
#pragma unroll
    for (int r2 = 0; r2 < 2; ++r2) { scv[r2] = __expf(scv[r2] - mx); sum += scv[r2]; }
    sum = wave_sum(sum);
    if (lane == 0) { St[(g * 2 + hf) * 2] = mx; St[(g * 2 + hf) * 2 + 1] = sum; }
    __syncthreads();
    {
        const float m0 = St[(g * 2 + 0) * 2], s0 = St[(g * 2 + 0) * 2 + 1], m1 = St[(g * 2 + 1) * 2], s1 = St[(g * 2 + 1) * 2 + 1];
        const float M = fmaxf(fmaxf(m0, m1), sink);
        const float inv = 1.f / (s0 * __expf(m0 - M) + s1 * __expf(m1 - M) + __expf(sink - M));
        const float sc = __expf(mx - M) * inv;
#pragma unroll
        for (int r2 = 0; r2 < 2; ++r2) { const int j = (hf == 0) ? lane + 128 * r2 : (r2 == 0 ? 64 + lane : 1000); if (j < 160) Ps[j] = scv[r2] * sc; }
    }
    __syncthreads();
    float o = 0.f;
    { const int j0 = hf ? 73 : 0, j1 = hf ? 145 : 73;
#pragma unroll 4
      for (int j = j0; j < j1; ++j) o += Ps[j] * bf2f(*(const LAS unsigned short*)(lds + S2_V + (j * S2_ROW + lane) * 2)); }
    if (hf == 1) Op[g * 64 + lane] = o;
    __syncthreads();
    if (hf == 0) {
        o += Op[g * 64 + lane];
        const float ga = bf2f(prow[C_GA + head * 64 + lane]);
        ((bf16*)(a.ws + WS_MIX))[row * DM + head * 64 + lane] = (bf16)f2bf(o * silu_f(ga));
    }
    __syncthreads();
}
constexpr int TAIL_ROW0 = 16384, TAIL_RT = (MS - TAIL_ROW0) / 16;
__device__ __forceinline__ void outproj_tail(const Args& a, int layer) {
    int tid_ = threadIdx.x; asm volatile("" : "+v"(tid_)); const int tid = tid_, lane = tid & 63, wave = tid >> 6, l15 = lane & 15, quad = lane >> 4;
    const int G = gridDim.x;
    const bf16* MIX = (const bf16*)(a.ws + WS_MIX); const bf16* W = (const bf16*)(a.ws + WS_WOUT) + (size_t)layer * DM * DM;
    bf16* XB = (bf16*)(a.ws + WS_XB); unsigned long long* ssn = (unsigned long long*)(a.ws + WS_SS) + (layer + 1 < DEPTH ? layer + 1 : 0) * MPAD;
    const int last = (layer == DEPTH - 1);
    for (int t = blockIdx.x + G * wave; t < TAIL_RT * 64; t += G * 8) {
        const int rt = t >> 6, ct = t & 63;
        const bf16* ap = MIX + (size_t)(TAIL_ROW0 + 16 * rt + l15) * DM + quad * 8;
        const bf16* bp = W + (size_t)(16 * ct + l15) * DM + quad * 8;
        f32x4 acc = {0.f, 0.f, 0.f, 0.f};
#pragma unroll 1
        for (int s0 = 0; s0 < 32; s0 += 8) {
            s16x8 af[8], bf[8];
#pragma unroll
            for (int u = 0; u < 8; ++u) { af[u] = *(const s16x8*)(ap + 32 * (s0 + u)); bf[u] = *(const s16x8*)(bp + 32 * (s0 + u)); }
#pragma unroll
            for (int u = 0; u < 8; ++u) acc = MFMA32(bf[u], af[u], acc);
        }
        const int row = TAIL_ROW0 + 16 * rt + l15, col = 16 * ct + quad * 4;
        const u32x2 xb = *(const u32x2*)(XB + (size_t)row * DM + col);
        const f32x4 v = (f32x4){bflo(xb.x), bfhi(xb.x), bflo(xb.y), bfhi(xb.y)} + acc;
        if (last) {
            float* yr = nullptr;
            if (row < MP) { const int b = row / LP, pos = row - b * LP; if (pos >= NMETA) yr = a.out + O_YP + ((size_t)b * SEQ + pos - NMETA) * DM + col; }
            else if (row < MS) yr = a.out + O_YS + (size_t)(row - MP) * DM + col;
            if (yr) *(f32x4*)yr = v;
        } else {
            *(u32x2*)(XB + (size_t)row * DM + col) = (u32x2){pk2(v[0], v[1]), pk2(v[2], v[3])};
            float part = v[0] * v[0] + v[1] * v[1] + v[2] * v[2] + v[3] * v[3];
            part += __shfl_xor(part, 16); part += __shfl_xor(part, 32);
            if (quad == 0) atomicAdd(ssn + row, (unsigned long long)(part * SS_SCALE));
        }
    }
}

#define XB_TMO      128
#define XB_XCNT(j)  (256  + 64 * (j))
#define XB_XSUB(j)  (1280 + 64 * (j))
#define XB_XGEN(j)  (2304 + 64 * (j))
#define XB_TOP      3328
#define XB_TOPGEN   3392
#define XCD_BAR_WORDS 3456
#define XB_SPIN_CAP (1u << 18)

__device__ __forceinline__ unsigned xb_ld(unsigned* p)              { return __hip_atomic_load(p, __ATOMIC_RELAXED, __HIP_MEMORY_SCOPE_AGENT); }
__device__ __forceinline__ unsigned xb_add(unsigned* p, unsigned v) { return __hip_atomic_fetch_add(p, v, __ATOMIC_RELAXED, __HIP_MEMORY_SCOPE_AGENT); }
__device__ __forceinline__ unsigned xb_xcc_id() { return (unsigned)__builtin_amdgcn_s_getreg((3 << 11) | 20) & 0xFu; }
#define XB_SPIN(cond, bar) do { unsigned _sp = 0; while (cond) { __builtin_amdgcn_s_sleep(1); \
    if ((++_sp & 255u) == 0u) { if (xb_ld(&(bar)[XB_TMO])) break; if (_sp > XB_SPIN_CAP) { atomicAdd(&(bar)[XB_TMO], 1u); break; } } } } while (0)

struct XcdBarrier {
    unsigned* bar; unsigned x;
    volatile LAS unsigned* st;
};

__device__ __forceinline__ XcdBarrier xcd_barrier_post(unsigned* bar, volatile LAS unsigned* st) {
    XcdBarrier b; b.bar = bar; b.x = xb_xcc_id(); b.st = st;
    if (threadIdx.x == 0) (void)xb_add(&bar[XB_XCNT(b.x)], 1u);
    return b;
}
__device__ __forceinline__ void xcd_barrier_complete(unsigned* bar, unsigned x, unsigned& nloc, unsigned& nx) {
    const unsigned G = gridDim.x * gridDim.y * gridDim.z;
    unsigned sum, cnt, mine, sp = 0u;
    for (;;) {
        sum = 0u; cnt = 0u; mine = 0u;
#pragma unroll
        for (unsigned j = 0; j < 16; ++j) { const unsigned c = xb_ld(&bar[XB_XCNT(j)]); sum += c; cnt += (c > 0u) ? 1u : 0u; mine = (j == x) ? c : mine; }
        if (sum == G) break;
        __builtin_amdgcn_s_sleep(1);
        if ((++sp & 255u) == 0u) { if (xb_ld(&bar[XB_TMO])) break; if (sp > XB_SPIN_CAP) { atomicAdd(&bar[XB_TMO], 1u); break; } }
    }
    nloc = mine > 0u ? mine : 1u; nx = cnt > 0u ? cnt : 1u;
}

__device__ __forceinline__ void xcd_barrier(const XcdBarrier& b) {
    asm volatile("s_waitcnt vmcnt(0)" ::: "memory");
    __syncthreads();
    if (threadIdx.x == 0) {
        unsigned* bar = b.bar;
        __builtin_amdgcn_s_waitcnt(0);
        unsigned nloc = b.st[0], nx = b.st[1];
        if (nloc == 0u) { xcd_barrier_complete(bar, b.x, nloc, nx); b.st[0] = nloc; b.st[1] = nx; }
        const unsigned old = xb_add(&bar[XB_XSUB(b.x)], 1u);
        const unsigned gen = old / nloc;
        if (old + 1u == (gen + 1u) * nloc) {
            __builtin_amdgcn_fence(__ATOMIC_RELEASE, "agent");
            asm volatile("s_waitcnt vmcnt(0)" ::: "memory");
            const unsigned og = xb_add(&bar[XB_TOP], 1u);
            const unsigned tg = og / nx;
            if (og + 1u == (tg + 1u) * nx) xb_add(&bar[XB_TOPGEN], 1u);
            else XB_SPIN(xb_ld(&bar[XB_TOPGEN]) == tg, bar);
            __builtin_amdgcn_fence(__ATOMIC_ACQUIRE, "agent");
            xb_add(&bar[XB_XGEN(b.x)], 1u);
            asm volatile("s_waitcnt vmcnt(0)" ::: "memory");
        } else {
            XB_SPIN(xb_ld(&bar[XB_XGEN(b.x)]) == gen, bar);
            __builtin_amdgcn_fence(__ATOMIC_ACQUIRE, "agent");
            asm volatile("s_waitcnt vmcnt(0)" ::: "memory");
        }
    }
    __syncthreads();
}

constexpr int N_PHASES = 1 + 5 * DEPTH;
__global__ void __launch_bounds__(NTHREADS, 2) hymba_fwd(Args a) {
    extern __shared__ __attribute__((aligned(16))) unsigned char lds_raw[];
    LAS unsigned char* lds = (LAS unsigned char*)lds_raw;
    const int G = gridDim.x, bx = blockIdx.x;
    if (threadIdx.x < 64) ((LAS unsigned*)(lds + MISC_OFF))[threadIdx.x] = 0u;
    __syncthreads();
    const XcdBarrier bar = xcd_barrier_post((unsigned*)(a.ws + WS_BAR), (volatile LAS unsigned*)(lds + MISC_OFF));
#ifndef REP_A
#define REP_A 1
#endif
#ifndef REP_P
#define REP_P 1
#endif
#ifndef REP_B
#define REP_B 1
#endif
#ifndef REP_B1
#define REP_B1 1
#endif
#ifndef REP_B2
#define REP_B2 1
#endif
#ifndef REP_B3
#define REP_B3 1
#endif
#ifndef REP_C
#define REP_C 1
#endif
#ifndef REP_D
#define REP_D 1
#endif
    for (int ph = a.ph_lo; ph < a.ph_hi; ++ph) {
#ifndef PHM
#define PHM 0xff
#endif
        if (ph == 0) { for (int rep = 0; rep < REP_P; ++rep) prologue(a, lds); }
        else {
            const int layer = (ph - 1) / 5, st = (ph - 1) % 5;
            if (st == 0) { if (PHM & 2) for (int rep = 0; rep < REP_A; ++rep) {
                pg8::Gemm g{(const pg8::bf16_t*)(a.ws + WS_XB), (const pg8::bf16_t*)(a.ws + WS_WIN) + (size_t)layer * PW * DM, MPAD, PW, DM};
                pg8::StaticOrder S; S.init(MPAD, PW, G, bx);
                EpiP E{(bf16*)(a.ws + WS_P), (const unsigned long long*)(a.ws + WS_SS) + layer * MPAD};
                pg8::gemm_phase<EpiP, pg8::StaticOrder, true, true>(lds, g, S, E); }
                { const int nun = (MPAD / 256) * (PW / 256), first = (G == 256) ? (nun - 3 * 256) : 0;
                  convert_layer(a, layer, first, lds); __syncthreads();
                }
            } else if (st == 1) {
                const bool first = (bx & 1) == 0;
                const int slot3 = bx % 3; const bool mid = (slot3 == 1);
                const int vb = (G % 8 == 0) ? (bx % 8) * (G / 8) + bx / 8 : bx;
                if (slot3 == 0) { for (int u = bx; u < DB * NKV; u += G) sattn2(a, layer, u, lds);
                    if (G == 256) hg_sample2(a, layer, bx, bx + 256, lds); else for (int u = bx; u < DB * HGH; u += G) hg_sample(a, layer, u, lds); }
                for (int u = vb; u < NB * 65 * NKV; u += G) pattn(a, layer, u, lds);
                if (mid) { for (int u = bx; u < DB * NKV; u += G) sattn2(a, layer, u, lds); hg_sample2(a, layer, bx, bx + 256, lds); }
                for (int u = vb; u < NB * HGH * NSC; u += G) hg_pass1(a, layer, u, lds);
                if (slot3 == 2) { for (int u = bx; u < DB * NKV; u += G) sattn2(a, layer, u, lds);
                    if (G == 256) hg_sample2(a, layer, bx, bx + 256, lds); else for (int u = bx; u < DB * HGH; u += G) hg_sample(a, layer, u, lds); }
            } else if (st == 2) { for (int rep = 0; rep < REP_C; ++rep) {
                hg_scan(a, layer);
                }
            } else if (st == 3) { for (int rep = 0; rep < REP_D; ++rep)
                for (int u = (G % 8 == 0) ? (bx % 8) * (G / 8) + bx / 8 : bx; u < NB * HGH * NSC; u += G) hg_pass2(a, layer, u, lds);
            } else if (PHM & 128) {
                constexpr int EM = TAIL_ROW0;
                if ((bx & 1) == 0) outproj_tail(a, layer);
                pg8::Gemm g{(const pg8::bf16_t*)(a.ws + WS_MIX), (const pg8::bf16_t*)(a.ws + WS_WOUT) + (size_t)layer * DM * DM, EM, DM, DM};
                pg8::StaticOrder S; S.init(EM, DM, G, bx);
                const int last = (layer == DEPTH - 1);
                EpiOut E{(bf16*)(a.ws + WS_XB), (unsigned long long*)(a.ws + WS_SS) + (layer + 1 < DEPTH ? layer + 1 : 0) * MPAD, a.out, last};
                pg8::gemm_phase<EpiOut, pg8::StaticOrder, true, true>(lds, g, S, E);
                if (bx & 1) outproj_tail(a, layer);
            }
        }
        if (ph + 1 < a.ph_hi) { if (a.ph_hi > 1000) cg::this_grid().sync(); else xcd_barrier(bar); }
    }
}

#ifndef MK_MULTI
#define MK_MULTI 0
#endif
extern "C" void kernel_launch(void* const* d_in, const int* in_sizes, int n_in, void* d_out, int out_size, void* d_ws, size_t ws_size, hipStream_t stream) {
    static int grid = 0;
    if (grid == 0) {
        if (n_in != 16 || (size_t)out_size != O_END || ws_size < WS_END) { fprintf(stderr, "kernel_launch: unexpected shapes (n_in %d out %d ws %zu)\n", n_in, out_size, ws_size); grid = -1; return; }
        int dev = 0, cus = 0, per_cu = 0;
        hipGetDevice(&dev); hipDeviceGetAttribute(&cus, hipDeviceAttributeMultiprocessorCount, dev);
        if (hipFuncSetAttribute((const void*)hymba_fwd, hipFuncAttributeMaxDynamicSharedMemorySize, LDS_BYTES) != hipSuccess) { fprintf(stderr, "kernel_launch: hipFuncSetAttribute failed\n"); grid = -1; return; }
        if (hipOccupancyMaxActiveBlocksPerMultiprocessor(&per_cu, (const void*)hymba_fwd, NTHREADS, LDS_BYTES) != hipSuccess || per_cu < 1) per_cu = 1;
        (void)hipGetLastError();
        grid = cus * 1;
        if (grid <= 0) grid = 256;
        if (grid != 256) { fprintf(stderr, "kernel_launch: built for a 256-CU device (one HGRN2 unit per workgroup); got %d CUs\n", grid); grid = -1; return; }
    }
    if (grid < 0) return;
    hipMemsetAsync((char*)d_ws + WS_SS, 0, CTL_ZERO_BYTES, stream);
    Args a{};
    for (int i = 0; i < 16; ++i) a.in[i] = (const float*)d_in[i];
    a.out = (float*)d_out; a.ws = (unsigned char*)d_ws;
#if MK_MULTI
    for (int ph = 0; ph < N_PHASES; ++ph) { a.ph_lo = ph; a.ph_hi = ph + 1; hipLaunchKernelGGL(hymba_fwd, dim3(grid), dim3(NTHREADS), LDS_BYTES, stream, a); }
#else
    a.ph_lo = 0; a.ph_hi = N_PHASES;
    void* args[] = {&a};
    hipError_t e = hipLaunchCooperativeKernel((const void*)hymba_fwd, dim3(grid), dim3(NTHREADS), args, LDS_BYTES, stream);
    if (e != hipSuccess) fprintf(stderr, "cooperative launch failed: %s (grid %d)\n", hipGetErrorString(e), grid);
#endif
}
```

```cpp
#include <hip/hip_runtime.h>
#include <hip/hip_cooperative_groups.h>
#include <cstdio>
#include <cstdint>
#define HG1_NEW 1
#define SATTN_IN_B 1
#define VCU_MAP 1
#define PATTN_TR 1
#define PATTN_NOSB 1
#define OL_LDS 1
#define P2_SB4 1
#define QH_LDS 1
#define TAIL_STAGGER 1
#define B_SLOT3 1
#define CONV_FIRST 1
namespace pg8 {
#define PG8_LAS __attribute__((address_space(3)))
typedef unsigned short bf16_t;
typedef short bf16x8 __attribute__((ext_vector_type(8)));
typedef float f32x4 __attribute__((ext_vector_type(4)));
typedef unsigned u32x4 __attribute__((ext_vector_type(4)));
constexpr int BM = 256, BK = 64, HALF = 128, HTB = HALF * BK * 2  , STAGE_BYTES = 8 * HTB, NXCD = 8, WGM = 8;

__host__ __device__ __forceinline__ int lds_byte(int r, int c) { const int st = (r >> 4) * 2 + (c >> 5), rr = r & 15, cc = c & 31, ob = rr * 64 + cc * 2; return st * 1024 + (ob ^ (((ob >> 9) & 1) << 5)); }
__host__ __device__ __forceinline__ void stage_rc(int b, int& R, int& C) { const int st = b / 1024, sb = b % 1024, swz = sb ^ (((sb >> 9) & 1) << 5); R = (st >> 1) * 16 + swz / 64; C = (st & 1) * 32 + (swz % 64) / 2; }
__host__ __device__ __forceinline__ int perm32(int rho) { const int n = rho >> 4, i = rho & 15; return 8 * (i >> 2) + 4 * n + (i & 3); }

struct Unit { int pm, pn; };
struct Gemm { const bf16_t* A; const bf16_t* Bt; int M, N, K; };

struct StaticOrder {
    int nM, nN, nwg, G, c;
    __host__ __device__ void init(int M, int N, int G_, int c_) { nM = M / BM; nN = N / BM; nwg = nM * nN; G = G_; c = c_; }
    __host__ __device__ bool next(int i, Unit& u) const {
        const long L = (long)i * G + c; if (L >= nwg) return false;
        int wgid = (int)L; { const int q = nwg / NXCD, r = nwg % NXCD, xcd = wgid % NXCD, off = wgid / NXCD; wgid = (xcd < r ? xcd * (q + 1) : r * (q + 1) + (xcd - r) * q) + off; }
        const int nig = WGM * nN, gid = wgid / nig, fm = gid * WGM, gsz = (nM - fm) < WGM ? (nM - fm) : WGM;
        u.pm = fm + ((wgid % nig) % gsz); u.pn = (wgid % nig) / gsz; return true;
    }
    __device__ __forceinline__ void a_ready(const Unit&) const {}
    __device__ __forceinline__ void done(const Unit&) const {}
};
__device__ __forceinline__ unsigned cvt_pk_bf16(float lo, float hi) { unsigned r; asm volatile("v_cvt_pk_bf16_f32 %0, %1, %2" : "=v"(r) : "v"(lo), "v"(hi)); return r; }
template <class Epi, class Sched, bool ALIGN_EPI = false, bool SP2 = false>
__device__ __forceinline__ void gemm_phase(PG8_LAS unsigned char* lds, const Gemm g, const Sched& S, const Epi& E) {
    int tid_ = threadIdx.x; asm volatile("" : "+v"(tid_)); const int tid = tid_, wid = __builtin_amdgcn_readfirstlane(tid >> 6), lane = tid & 63, wr = wid >> 2, wc = wid & 3, fr = lane & 15, fq = lane >> 4;
    const int K = g.K, nt = K / BK;
    unsigned voffA[2], voffB[2];
#pragma unroll
    for (int i = 0; i < 2; ++i) { int R, C; stage_rc(tid * 16 + i * 8192, R, C); const int Rb = Epi::PERM ? ((R & ~31) + perm32(R & 31)) : R;
        voffA[i] = (unsigned)(R * K + C) * 2u; voffB[i] = (unsigned)(Rb * K + C) * 2u; }
    const size_t kstep = (size_t)(BK * 2);
    const size_t hstep = (size_t)HALF * K * 2;
    const size_t tstep = 2 * hstep;
    const unsigned ldsw = (unsigned)wid * 1024u;
    const int aoff = lds_byte(wr * 64 + fr, fq * 8), boff = lds_byte(wc * 32 + fr, fq * 8);
#define PG8_SA(b, h) (((b) * 2 + (h)) * HTB)
#define PG8_SB(b, h) ((4 + (b) * 2 + (h)) * HTB)
#define PG8_STAGE(bufoff, gbase, voff) do { _Pragma("unroll") for (int _i = 0; _i < 2; ++_i) \
        __builtin_amdgcn_global_load_lds((const unsigned*)((const char*)(gbase) + (voff)[_i]), (PG8_LAS unsigned*)(lds + (bufoff) + ldsw + _i * 8192), 16, 0, 0); } while (0)
#define PG8_LDA(dst, b, h) do { _Pragma("unroll") for (int m = 0; m < 4; ++m) _Pragma("unroll") for (int k = 0; k < 2; ++k) dst[m][k] = *(const PG8_LAS bf16x8*)(lds + PG8_SA(b, h) + aoff + m * 2048 + k * 1024); } while (0)
#define PG8_LDB(dst, b, h) do { _Pragma("unroll") for (int n = 0; n < 2; ++n) _Pragma("unroll") for (int k = 0; k < 2; ++k) dst[n][k] = *(const PG8_LAS bf16x8*)(lds + PG8_SB(b, h) + boff + n * 2048 + k * 1024); } while (0)
#define PG8_MMA(ai, bj, At, Bt) do { __builtin_amdgcn_s_setprio(1); _Pragma("unroll") for (int m = 0; m < 4; ++m) _Pragma("unroll") for (int n = 0; n < 2; ++n) _Pragma("unroll") for (int k = 0; k < 2; ++k) \
        acc[ai][bj][m][n] = __builtin_amdgcn_mfma_f32_16x16x32_bf16(Bt[n][k], At[m][k], acc[ai][bj][m][n], 0, 0, 0); __builtin_amdgcn_s_setprio(0); } while (0)
#define PG8_WAIT_V(n) asm volatile("s_waitcnt vmcnt(" #n ")" ::: "memory")
#define PG8_WAIT_L(n) asm volatile("s_waitcnt lgkmcnt(" #n ")" ::: "memory")
#define PG8_BAR __builtin_amdgcn_s_barrier()
#define PG8_SCHED __builtin_amdgcn_sched_barrier(0)
    Unit cur, nxt; int ui = 0;
    if (!S.next(0, cur)) return;
    f32x4 acc[2][2][4][2];
#pragma unroll
    for (int a = 0; a < 2; ++a)
#pragma unroll
        for (int b = 0; b < 2; ++b)
#pragma unroll
            for (int m = 0; m < 4; ++m)
#pragma unroll
                for (int n = 0; n < 2; ++n) acc[a][b][m][n] = (f32x4){0.f, 0.f, 0.f, 0.f};
    bf16x8 At[4][2], B0[2][2], B1[2][2];
    const char* cA = (const char*)g.A + (size_t)cur.pm * tstep; const char* cB = (const char*)g.Bt + (size_t)cur.pn * tstep;
    S.a_ready(cur);
    if constexpr (SP2) {
        PG8_STAGE(PG8_SB(0, 0), cB, voffB); PG8_STAGE(PG8_SB(0, 1), cB + hstep, voffB); PG8_STAGE(PG8_SA(0, 0), cA, voffA); PG8_STAGE(PG8_SA(0, 1), cA + hstep, voffA);
        if (wr == 1) PG8_BAR;
        PG8_WAIT_V(2); PG8_BAR;
        PG8_STAGE(PG8_SB(1, 0), cB + kstep, voffB); PG8_STAGE(PG8_SA(1, 0), cA + kstep, voffA); PG8_STAGE(PG8_SB(1, 1), cB + hstep + kstep, voffB);
        PG8_WAIT_V(6); PG8_BAR;
    } else {
        PG8_STAGE(PG8_SB(0, 0), cB, voffB); PG8_STAGE(PG8_SA(0, 0), cA, voffA); PG8_STAGE(PG8_SB(0, 1), cB + hstep, voffB); PG8_STAGE(PG8_SA(0, 1), cA + hstep, voffA);
        if (wr == 1) PG8_BAR;
        PG8_WAIT_V(4); PG8_BAR;
        PG8_STAGE(PG8_SB(1, 0), cB + kstep, voffB); PG8_STAGE(PG8_SA(1, 0), cA + kstep, voffA); PG8_STAGE(PG8_SB(1, 1), cB + hstep + kstep, voffB);
        PG8_WAIT_V(6); PG8_BAR;
    }
    for (;;) {
        const bool has_next = S.next(ui + 1, nxt);
        const char* nA = has_next ? (const char*)g.A + (size_t)nxt.pm * tstep : cA; const char* nB = has_next ? (const char*)g.Bt + (size_t)nxt.pn * tstep : cB;
        for (int t = 0; t < nt; t += 2) {
            const bool last = (t == nt - 2);
            const char* a1 = cA + (size_t)(t + 1) * kstep;
            const char* a2 = last ? nA : cA + (size_t)(t + 2) * kstep; const char* b2 = last ? nB : cB + (size_t)(t + 2) * kstep;
            const char* a3 = a2 + kstep; const char* b3 = b2 + kstep;
            if (last && has_next) S.a_ready(nxt);
            if constexpr (SP2) {
            PG8_LDB(B0, 0, 0); PG8_LDB(B1, 0, 1); PG8_SCHED; PG8_LDA(At, 0, 0); PG8_STAGE(PG8_SA(1, 1), a1 + hstep, voffA);
            PG8_WAIT_V(8); PG8_WAIT_L(0); PG8_BAR; PG8_MMA(0, 0, At, B0); PG8_MMA(0, 1, At, B1); PG8_BAR; PG8_SCHED;
            PG8_LDA(At, 0, 1); PG8_STAGE(PG8_SB(0, 0), b2, voffB); PG8_STAGE(PG8_SB(0, 1), b2 + hstep, voffB); PG8_STAGE(PG8_SA(0, 0), a2, voffA);
            PG8_WAIT_V(8); PG8_WAIT_L(0); PG8_BAR; PG8_MMA(1, 0, At, B0); PG8_MMA(1, 1, At, B1); PG8_BAR; PG8_SCHED;
            PG8_LDB(B0, 1, 0); PG8_LDB(B1, 1, 1); PG8_SCHED; PG8_LDA(At, 1, 0); PG8_STAGE(PG8_SA(0, 1), a2 + hstep, voffA);
            PG8_WAIT_V(8); PG8_WAIT_L(0); PG8_BAR; PG8_MMA(0, 0, At, B0); PG8_MMA(0, 1, At, B1); PG8_BAR; PG8_SCHED;
            PG8_LDA(At, 1, 1); PG8_STAGE(PG8_SB(1, 0), b3, voffB); PG8_STAGE(PG8_SB(1, 1), b3 + hstep, voffB); PG8_STAGE(PG8_SA(1, 0), a3, voffA);
            PG8_WAIT_V(8); PG8_WAIT_L(0); PG8_BAR; PG8_MMA(1, 0, At, B0); PG8_MMA(1, 1, At, B1); PG8_BAR; PG8_SCHED;
            } else {
            PG8_LDB(B0, 0, 0); PG8_SCHED; PG8_LDA(At, 0, 0); PG8_STAGE(PG8_SA(1, 1), a1 + hstep, voffA);
            PG8_WAIT_L(8); PG8_BAR; PG8_WAIT_L(0); PG8_MMA(0, 0, At, B0); PG8_BAR; PG8_SCHED;
            PG8_LDB(B1, 0, 1); PG8_STAGE(PG8_SB(0, 0), b2, voffB);
            PG8_BAR; PG8_WAIT_L(0); PG8_MMA(0, 1, At, B1); PG8_BAR;
            PG8_LDA(At, 0, 1); PG8_STAGE(PG8_SA(0, 0), a2, voffA);
            PG8_BAR; PG8_WAIT_L(0); PG8_MMA(1, 0, At, B0); PG8_BAR; PG8_SCHED;
            PG8_STAGE(PG8_SB(0, 1), b2 + hstep, voffB);
            PG8_WAIT_V(6); PG8_BAR; PG8_MMA(1, 1, At, B1); PG8_BAR;
            PG8_LDB(B0, 1, 0); PG8_SCHED; PG8_LDA(At, 1, 0); PG8_STAGE(PG8_SA(0, 1), a2 + hstep, voffA);
            PG8_WAIT_L(8); PG8_BAR; PG8_WAIT_L(0); PG8_MMA(0, 0, At, B0); PG8_BAR; PG8_SCHED;
            PG8_LDB(B1, 1, 1); PG8_STAGE(PG8_SB(1, 0), b3, voffB);
            PG8_BAR; PG8_WAIT_L(0); PG8_MMA(0, 1, At, B1); PG8_BAR;
            PG8_LDA(At, 1, 1); PG8_STAGE(PG8_SA(1, 0), a3, voffA);
            PG8_BAR; PG8_WAIT_L(0); PG8_MMA(1, 0, At, B0); PG8_BAR; PG8_SCHED;
            PG8_STAGE(PG8_SB(1, 1), b3 + hstep, voffB);
            PG8_WAIT_V(6); PG8_BAR; PG8_MMA(1, 1, At, B1); PG8_BAR;
            }
        }
        if constexpr (ALIGN_EPI) { if (wr == 0) PG8_BAR; }
        if constexpr (!Epi::AFTER_DRAIN) { E(acc, cur, wr, wc, fr, fq); S.done(cur); }
        if (!has_next) break;
#pragma unroll
        for (int a = 0; a < 2; ++a)
#pragma unroll
            for (int b = 0; b < 2; ++b)
#pragma unroll
                for (int m = 0; m < 4; ++m)
#pragma unroll
                    for (int n = 0; n < 2; ++n) acc[a][b][m][n] = (f32x4){0.f, 0.f, 0.f, 0.f};
        cur = nxt; cA = nA; cB = nB; ++ui;
        if constexpr (ALIGN_EPI) { if (wr == 1) PG8_BAR; }
    }
    PG8_WAIT_V(0);
    if constexpr (!ALIGN_EPI) { if (wr == 0) PG8_BAR; }
    PG8_BAR;
    if constexpr (Epi::AFTER_DRAIN) { E.fused(acc, cur, wr, wc, fr, fq, lds, wid, lane); S.done(cur); }
#undef PG8_SA
#undef PG8_SB
#undef PG8_STAGE
#undef PG8_LDA
#undef PG8_LDB
#undef PG8_MMA
#undef PG8_WAIT_V
#undef PG8_WAIT_L
#undef PG8_BAR
#undef PG8_SCHED
}
}

namespace cg = cooperative_groups;
#define GAS __attribute__((address_space(1)))
#define LAS __attribute__((address_space(3)))
typedef unsigned short bf16;
typedef float f32x4 __attribute__((ext_vector_type(4)));
typedef short s16x8 __attribute__((ext_vector_type(8)));
typedef short s16x4 __attribute__((ext_vector_type(4)));
typedef unsigned u32x4 __attribute__((ext_vector_type(4)));
typedef unsigned u32x2 __attribute__((ext_vector_type(2)));

constexpr int DM = 1024, NB = 2, SEQ = 8192, DEPTH = 4, DB = 128, NMETA = 16, WIN = 128, HD = 64, NQH = 8, NKV = 2;
constexpr int HGH = 4, HK = 128, HV = 128, PW = 3328;
constexpr int LP = SEQ + NMETA;
constexpr int MP = NB * LP;
constexpr int MS = MP + DB;
constexpr int MPAD = 16640;
constexpr int C_QA = 0, C_KA = 512, C_VA = 640, C_GA = 768, C_QH = 1280, C_FH = 1792, C_IH = 2304, C_GH = 2816;
constexpr int NSC = 32;
constexpr float EPS = 1e-6f;
constexpr int NTHREADS = 512;
#ifdef OL_LDS
constexpr int LDS_BYTES = 163840;
#ifdef QH_LDS
constexpr int OLDS_OFF = 47104, OLDS_ROW = 264;
constexpr int QLDS_OFF = 118912, QLDS_ROW = 272;
#else
constexpr int OLDS_OFF = 86016, OLDS_ROW = 264;
#endif
#else
constexpr int LDS_BYTES = 147456;
#endif

constexpr size_t MiB = 1u << 20;
constexpr size_t WS_SS = 0, CTL_ZERO_BYTES = 1 * MiB;
constexpr float SS_SCALE = 16777216.f;
constexpr size_t WS_LB = 1 * MiB;
constexpr size_t WS_WIN = 2 * MiB;
constexpr size_t WS_WOUT = 28 * MiB;
constexpr size_t WS_XB = 36 * MiB;
constexpr size_t WS_X = 69 * MiB;
constexpr size_t WS_P = 134 * MiB;
constexpr size_t WS_MIX = 240 * MiB;
constexpr size_t WS_L = 273 * MiB;
constexpr size_t WS_D = 290 * MiB;
constexpr size_t WS_FLAG = 900 * 1024;
constexpr size_t WS_BAR = 768 * 1024;
constexpr size_t WS_QH = 291 * MiB;
constexpr size_t WS_OL = 308 * MiB;
constexpr size_t WS_S = 325 * MiB;
constexpr size_t WS_END = 342 * MiB;
#ifdef OL_LDS
constexpr int MISC_OFF = 159744;
#else
constexpr int MISC_OFF = 131072;
#endif

constexpr size_t O_YP = 0, O_YS = O_YP + (size_t)NB * SEQ * DM, O_WKP = O_YS + (size_t)DB * DM, O_WVP = O_WKP + 131072, O_MKP = O_WVP + 131072,
                 O_MVP = O_MKP + 16384, O_HP = O_MVP + 16384, O_WKS = O_HP + 524288, O_WVS = O_WKS + 8388608, O_HS = O_WVS + 8388608, O_END = O_HS + 33554432;

struct Args { const float* in[16]; float* out; unsigned char* ws; int ph_lo, ph_hi; };

__device__ __forceinline__ float bflo(unsigned u) { return __builtin_bit_cast(float, u << 16); }
__device__ __forceinline__ float bfhi(unsigned u) { return __builtin_bit_cast(float, u & 0xffff0000u); }
__device__ __forceinline__ float bf2f(unsigned short h) { return __builtin_bit_cast(float, (unsigned)h << 16); }
__device__ __forceinline__ unsigned f2bf(float f) { unsigned u = __builtin_bit_cast(unsigned, f); return (u + 0x7fffu + ((u >> 16) & 1u)) >> 16; }
typedef float f32x2_t __attribute__((ext_vector_type(2)));
typedef __bf16 bf16x2_t __attribute__((ext_vector_type(2)));
__device__ __forceinline__ unsigned pk2(float lo, float hi) { f32x2_t v = {lo, hi}; bf16x2_t b = __builtin_convertvector(v, bf16x2_t); return __builtin_bit_cast(unsigned, b); }
__device__ __forceinline__ unsigned pk2s(float lo, float hi) {
    const unsigned a = __builtin_bit_cast(unsigned, lo) + 0x8000u, b = __builtin_bit_cast(unsigned, hi) + 0x8000u;
    return __builtin_amdgcn_perm(b, a, 0x07060302u);
}
__device__ __forceinline__ f32x4 zero_acc() { f32x4 z = {0.f, 0.f, 0.f, 0.f}; asm volatile("" : "+v"(z)); return z; }
__device__ __forceinline__ float silu_f(float x) { return x * __builtin_amdgcn_rcpf(1.f + __expf(-x)); }
__device__ __forceinline__ float wave_sum(float v) {
#pragma unroll
    for (int o = 1; o < 64; o <<= 1) v += __shfl_xor(v, o);
    return v;
}
__device__ __forceinline__ float wave_max(float v) {
#pragma unroll
    for (int o = 1; o < 64; o <<= 1) v = fmaxf(v, __shfl_xor(v, o));
    return v;
}
#define MFMA32(a, b, c) __builtin_amdgcn_mfma_f32_16x16x32_bf16((a), (b), (c), 0, 0, 0)
#define MFMA_DRAIN() do { __builtin_amdgcn_sched_barrier(0); asm volatile("s_nop 15\n\ts_nop 15"); __builtin_amdgcn_sched_barrier(0); } while (0)
#define CVT_GAP() do { __builtin_amdgcn_sched_barrier(0); asm volatile("s_nop 3"); __builtin_amdgcn_sched_barrier(0); } while (0)
#define MFMA16(a, b, c) __builtin_amdgcn_mfma_f32_16x16x16bf16_1k((a), (b), (c), 0, 0, 0)
#define LDS_WAIT() asm volatile("s_waitcnt lgkmcnt(0)" ::: "memory")

struct EpiP {
    static constexpr bool PERM = true, AFTER_DRAIN = false;
    bf16* P; const unsigned long long* ss;
    __device__ __forceinline__ void operator()(const pg8::f32x4 (&acc)[2][2][4][2], const pg8::Unit& u, int wr, int wc, int fr, int fq) const {
        const int row0 = u.pm * 256 + wr * 64 + fr, col0 = u.pn * 256 + wc * 32 + 8 * fq;
        unsigned long long sv[8];
#pragma unroll
        for (int g = 0; g < 8; ++g) sv[g] = ss[row0 + (g >> 2) * 128 + (g & 3) * 16];
#pragma unroll
        for (int ai = 0; ai < 2; ++ai)
#pragma unroll
            for (int m = 0; m < 4; ++m) {
                const int row = row0 + ai * 128 + m * 16;
                const float rs = rsqrtf((float)sv[ai * 4 + m] * (1.f / (SS_SCALE * DM)) + EPS);
                bf16* rowp = P + (size_t)row * PW + col0;
#pragma unroll
                for (int bj = 0; bj < 2; ++bj) {
                    const pg8::f32x4 v0 = acc[ai][bj][m][0] * rs, v1 = acc[ai][bj][m][1] * rs;
                    u32x4 w; w.x = pk2(v0[0], v0[1]); w.y = pk2(v0[2], v0[3]); w.z = pk2(v1[0], v1[1]); w.w = pk2(v1[2], v1[3]);
#ifdef P_NT
                    __builtin_nontemporal_store(w, (u32x4*)(rowp + bj * 128));
#else
                    *(u32x4*)(rowp + bj * 128) = w;
#endif
                }
            }
    }
};
struct EpiOut {
    static constexpr bool PERM = true, AFTER_DRAIN = false;
    bf16* XB; unsigned long long* ssn; float* out; int last;
    __device__ __forceinline__ void operator()(const pg8::f32x4 (&acc)[2][2][4][2], const pg8::Unit& u, int wr, int wc, int fr, int fq) const {
        const int row0 = u.pm * 256 + wr * 64 + fr, col0 = u.pn * 256 + wc * 32 + 8 * fq;
#pragma unroll
        for (int ai = 0; ai < 2; ++ai) {
            u32x4 xv[1][4][2];
#pragma unroll
            for (int m = 0; m < 4; ++m) { const bf16* xr = XB + (size_t)(row0 + ai * 128 + m * 16) * DM + col0;
#pragma unroll
                for (int bj = 0; bj < 2; ++bj) xv[0][m][bj] = *(const u32x4*)(xr + bj * 128); }
#pragma unroll
            for (int m = 0; m < 4; ++m) {
                const int row = row0 + ai * 128 + m * 16;
                float part = 0.f;
                float* yr = nullptr;
                if (last) {
                    if (row < MP) { const int b = row / LP, pos = row - b * LP; if (pos >= NMETA) yr = out + O_YP + ((size_t)b * SEQ + pos - NMETA) * DM + col0; }
                    else if (row < MS) yr = out + O_YS + (size_t)(row - MP) * DM + col0;
                }
#pragma unroll
                for (int bj = 0; bj < 2; ++bj) {
                    const u32x4 xb = xv[0][m][bj];
                    const pg8::f32x4 x0 = {bflo(xb.x), bfhi(xb.x), bflo(xb.y), bfhi(xb.y)}, x1 = {bflo(xb.z), bfhi(xb.z), bflo(xb.w), bfhi(xb.w)};
                    const pg8::f32x4 v0 = x0 + acc[ai][bj][m][0], v1 = x1 + acc[ai][bj][m][1];
                    if (last) {
                        if (yr) { __builtin_nontemporal_store(v0, (pg8::f32x4*)(yr + bj * 128)); __builtin_nontemporal_store(v1, (pg8::f32x4*)(yr + bj * 128 + 4)); }
                    } else {
                        u32x4 w; w.x = pk2(v0[0], v0[1]); w.y = pk2(v0[2], v0[3]); w.z = pk2(v1[0], v1[1]); w.w = pk2(v1[2], v1[3]);
                        *(u32x4*)(XB + (size_t)row * DM + col0 + bj * 128) = w;
                        part += v0[0] * v0[0] + v0[1] * v0[1] + v0[2] * v0[2] + v0[3] * v0[3] + v1[0] * v1[0] + v1[1] * v1[1] + v1[2] * v1[2] + v1[3] * v1[3];
                    }
                }
                if (!last) {
                    part += __shfl_xor(part, 16); part += __shfl_xor(part, 32);
                    if (fq == 0) atomicAdd(ssn + row, (unsigned long long)(part * SS_SCALE));
                }
            }
        }
    }
};

struct OrderA {
    pg8::StaticOrder so; unsigned* flag;
    __device__ __forceinline__ bool next(int i, pg8::Unit& u) const {
        const long L = (long)i * so.G + so.c; if (L >= so.nwg) return false;
        pg8::StaticOrder t = so; t.c = (int)(so.nwg - 1 - L); t.G = so.nwg;
        return t.next(0, u);
    }
    __device__ __forceinline__ void a_ready(const pg8::Unit&) const {}
    __device__ __forceinline__ void done(const pg8::Unit& u) const {
        if (u.pm == MPAD / 256 - 1) {
            asm volatile("s_waitcnt vmcnt(0)" ::: "memory");
            __builtin_amdgcn_fence(__ATOMIC_RELEASE, "agent");
            asm volatile("s_waitcnt vmcnt(0)" ::: "memory");
            if ((threadIdx.x & 63) == 0) __hip_atomic_fetch_add(flag, 1u, __ATOMIC_RELAXED, __HIP_MEMORY_SCOPE_AGENT);
        }
    }
};
constexpr unsigned SAMPLE_P_WAVES = (PW / 256) * 8;

__device__ __forceinline__ void transpose_item(const float* W, int K, int N, bf16* WT, const float* scale, LAS float* scr, int item, int lane) {
    const int nblk = N / 32, kb = item / nblk, nb = item % nblk, k0 = 64 * kb, n0 = 32 * nb;
    float wv[32];
#pragma unroll
    for (int i = 0; i < 32; ++i) wv[i] = __builtin_nontemporal_load(W + (size_t)(k0 + 2 * i + (lane >> 5)) * N + n0 + (lane & 31));
#pragma unroll
    for (int i = 0; i < 32; ++i) { const int kk = 2 * i + (lane >> 5); const float s = scale ? scale[k0 + kk] : 1.f; scr[kk * 33 + (lane & 31)] = wv[i] * s; }
    LDS_WAIT();
    const int c = lane & 7;
#pragma unroll
    for (int j = 0; j < 4; ++j) { const int n = (lane >> 3) + 8 * j; const LAS float* s = scr + (8 * c) * 33 + n;
        u32x4 o; o.x = pk2(s[0 * 33], s[1 * 33]); o.y = pk2(s[2 * 33], s[3 * 33]); o.z = pk2(s[4 * 33], s[5 * 33]); o.w = pk2(s[6 * 33], s[7 * 33]);
        *(u32x4*)(WT + (size_t)(n0 + n) * K + k0 + 8 * c) = o; }
    LDS_WAIT();
}

__device__ __forceinline__ void prologue(const Args& a, LAS unsigned char* lds) {
    int tid_ = threadIdx.x; asm volatile("" : "+v"(tid_)); const int tid = tid_, lane = tid & 63, wave = tid >> 6, G = gridDim.x;
    const int gw = blockIdx.x * 8 + wave, NGW = G * 8;
    LAS float* scr = (LAS float*)(lds + wave * 8704);
    bf16* Win_t = (bf16*)(a.ws + WS_WIN);
    constexpr int I_IN = (DM / 64) * (PW / 32);
    for (int it = gw; it < I_IN; it += NGW) transpose_item(a.in[9], DM, PW, Win_t, a.in[8], scr, it, lane);
    bf16* XB = (bf16*)(a.ws + WS_XB); unsigned long long* ss0 = (unsigned long long*)(a.ws + WS_SS);
    for (int row0 = gw; row0 < MPAD; row0 += 4 * NGW) {
        f32x4 v[4][4]; float sq[4];
#pragma unroll
        for (int r = 0; r < 4; ++r) {
            const int row = row0 + r * NGW;
            const float* src = nullptr;
            if (row < MP) { const int b = row / LP, pos = row - b * LP; src = pos < NMETA ? a.in[7] + (size_t)pos * DM : a.in[0] + ((size_t)b * SEQ + pos - NMETA) * DM; }
            else if (row < MS) src = a.in[1] + (size_t)(row - MP) * DM;
#pragma unroll
            for (int j = 0; j < 4; ++j) v[r][j] = src ? __builtin_nontemporal_load((const f32x4*)src + lane + 64 * j) : (f32x4){0.f, 0.f, 0.f, 0.f};
        }
#pragma unroll
        for (int r = 0; r < 4; ++r) {
            float t = 0.f;
#pragma unroll
            for (int j = 0; j < 4; ++j) t += v[r][j][0] * v[r][j][0] + v[r][j][1] * v[r][j][1] + v[r][j][2] * v[r][j][2] + v[r][j][3] * v[r][j][3];
            sq[r] = wave_sum(t);
        }
#pragma unroll
        for (int r = 0; r < 4; ++r) {
            const int row = row0 + r * NGW;
            if (row < MPAD) {
#pragma unroll
                for (int j = 0; j < 4; ++j) { u32x2 w; w.x = pk2(v[r][j][0], v[r][j][1]); w.y = pk2(v[r][j][2], v[r][j][3]); *((u32x2*)(XB + (size_t)row * DM) + lane + 64 * j) = w; }
                if (lane == 0) ss0[row] = (unsigned long long)(sq[r] * SS_SCALE);
            }
        }
    }
    if (blockIdx.x == 0) {
        const float* lg = a.in[13]; float* lb = (float*)(a.ws + WS_LB);
        const float l0 = lg[tid], l1 = lg[512 + tid], l2 = lg[1024 + tid], l3 = lg[1536 + tid];
        const float mx = fmaxf(fmaxf(l0, l1), fmaxf(l2, l3));
        const float e0 = __expf(l0 - mx), e1 = __expf(l1 - mx), e2 = __expf(l2 - mx), e3 = __expf(l3 - mx), inv = 1.f / (e0 + e1 + e2 + e3);
        lb[tid] = 0.f; lb[512 + tid] = e1 * inv; lb[1024 + tid] = (e1 + e2) * inv; lb[1536 + tid] = (e1 + e2 + e3) * inv;
    }
    __syncthreads();
}

__device__ __forceinline__ void convert_layer(const Args& a, int l, int first, LAS unsigned char* lds) {
    int tid_ = threadIdx.x; asm volatile("" : "+v"(tid_)); const int tid = tid_, lane = tid & 63, wave = tid >> 6;
    const int G = gridDim.x, nb = G - first, me = (int)blockIdx.x - first;
    if (me < 0 || nb <= 0) return;
    LAS float* scr = (LAS float*)(lds + wave * 8704);
    constexpr int I_IN = (DM / 64) * (PW / 32), I_OUT = (DM / 64) * (DM / 32);
    const int li = l + 1, n_in = (li < DEPTH) ? I_IN : 0;
    bf16* Win_t = (bf16*)(a.ws + WS_WIN) + (size_t)li * PW * DM; bf16* Wout_t = (bf16*)(a.ws + WS_WOUT) + (size_t)l * DM * DM;
    for (int it = me * 8 + wave; it < I_OUT + n_in; it += nb * 8) {
        if (it < I_OUT) transpose_item(a.in[15] + (size_t)l * DM * DM, DM, DM, Wout_t, nullptr, scr, it, lane);
        else transpose_item(a.in[9] + (size_t)li * DM * PW, DM, PW, Win_t, a.in[8] + li * DM, scr, it - I_OUT, lane);
    }
}

#ifdef HG1_NEW
constexpr int H1_QT = 0, H1_KP = H1_QT + 4352, H1_KBT = H1_KP + 4352, H1_VT = H1_KBT + 5120, H1_DS = H1_VT + 5120, H1_BUF = H1_DS + 512, H1_TROW = 20;
__device__ __forceinline__ void hg_pass1(const Args& a, int layer, int unit, LAS unsigned char* lds) {
    int tid_ = threadIdx.x; asm volatile("" : "+v"(tid_)); const int tid = tid_, lane = tid & 63, wave = tid >> 6, l15 = lane & 15, quad = lane >> 4;
    const int b = unit / (HGH * NSC), h = (unit / NSC) % HGH, sc = unit % NSC;
    const int nsub = (sc == NSC - 1) ? 17 : 16;
    const int tg = quad, k = 16 * wave + l15;
    const bf16* P = (const bf16*)(a.ws + WS_P);
    const float lb = ((const float*)(a.ws + WS_LB))[layer * 512 + h * 128 + k];
    const size_t row0 = (size_t)b * LP + (size_t)sc * 256;
    float gacc = 0.f;
    f32x4 S[8];
#pragma unroll
    for (int kt = 0; kt < 8; ++kt) S[kt] = (f32x4){0.f, 0.f, 0.f, 0.f};
    unsigned short zn[4], qn[4], vn[4];
    { const bf16* pn = P + (row0 + 4 * tg) * PW + h * 128 + k;
#pragma unroll
      for (int e = 0; e < 4; ++e) { zn[e] = pn[e * PW + C_FH]; qn[e] = pn[e * PW + C_QH]; vn[e] = pn[e * PW + C_IH]; } }
    bf16* QH = (bf16*)(a.ws + WS_QH) + (row0 + 4 * tg) * 512 + h * 128 + k;
    for (int i = 0; i < nsub; ++i) {
        LAS unsigned char* buf = lds + (i & 1) * H1_BUF;
#ifdef EXP_VM0
        asm volatile("s_waitcnt vmcnt(0)" ::: "memory");
#endif
        float z[4], q[4]; unsigned short vr[4];
#pragma unroll
        for (int e = 0; e < 4; ++e) { z[e] = bf2f(zn[e]); q[e] = bf2f(qn[e]); vr[e] = vn[e]; }
        if (i + 1 < nsub) { const bf16* pn = P + (row0 + 16 * (i + 1) + 4 * tg) * PW + h * 128 + k;
#pragma unroll
            for (int e = 0; e < 4; ++e) { zn[e] = pn[e * PW + C_FH]; qn[e] = pn[e * PW + C_QH]; vn[e] = pn[e * PW + C_IH]; } }
        float c[4], kk[4], qs[4];
#pragma unroll
        for (int e = 0; e < 4; ++e) {
#ifdef EXP_DIV
            const float sig = 1.f / (1.f + __expf(-z[e])), sigm = 1.f / (1.f + __expf(z[e]));
            const float f = lb + (1.f - lb) * sig;
            c[e] = __logf(fmaxf(f, 1e-30f)); kk[e] = (1.f - lb) * sigm; qs[e] = q[e] / (1.f + __expf(-q[e]));
#else
            const float sig = __builtin_amdgcn_rcpf(1.f + __expf(-z[e]));
            const float f = lb + (1.f - lb) * sig;
            c[e] = __logf(fmaxf(f, 1e-30f)); kk[e] = (1.f - lb) * (1.f - sig); qs[e] = silu_f(q[e]);
#endif
        }
        c[1] += c[0]; c[2] += c[1]; c[3] += c[2];
        const float T = c[3];
        float sincl = T, x = __shfl_up(sincl, 16);
        if (tg >= 1) sincl += x;
        x = __shfl_up(sincl, 32);
        if (tg >= 2) sincl += x;
        const float off = sincl - T, ce = __shfl(sincl, 48 + l15);
        float qt[4], kp[4], kb[4], qh[4];
        const float egacc = __expf(gacc);
#pragma unroll
        for (int e = 0; e < 4; ++e) {
            const float ct = off + c[e];
            qt[e] = qs[e] * __expf(ct); kp[e] = kk[e] * __expf(fminf(-ct, 80.f)); kb[e] = kk[e] * __expf(ce - ct); qh[e] = qt[e] * egacc;
        }
        const unsigned qt01 = pk2(qt[0], qt[1]), qt23 = pk2(qt[2], qt[3]), kp01 = pk2(kp[0], kp[1]), kp23 = pk2(kp[2], kp[3]), qh01 = pk2(qh[0], qh[1]), qh23 = pk2(qh[2], qh[3]);
        LAS unsigned short* qtp = (LAS unsigned short*)(buf + H1_QT) + (4 * tg) * 136 + k;
        qtp[0] = (unsigned short)qt01; qtp[136] = (unsigned short)(qt01 >> 16); qtp[272] = (unsigned short)qt23; qtp[408] = (unsigned short)(qt23 >> 16);
        LAS unsigned short* kpp = (LAS unsigned short*)(buf + H1_KP) + (4 * tg) * 136 + k;
        kpp[0] = (unsigned short)kp01; kpp[136] = (unsigned short)(kp01 >> 16); kpp[272] = (unsigned short)kp23; kpp[408] = (unsigned short)(kp23 >> 16);
        *(LAS u32x2*)(buf + H1_KBT + (k * H1_TROW + 4 * tg) * 2) = (u32x2){pk2(kb[0], kb[1]), pk2(kb[2], kb[3])};
        *(LAS u32x2*)(buf + H1_VT + (k * H1_TROW + 4 * tg) * 2) = (u32x2){(unsigned)vr[0] | ((unsigned)vr[1] << 16), (unsigned)vr[2] | ((unsigned)vr[3] << 16)};
        if (tg == 0) *(LAS float*)(buf + H1_DS + k * 4) = __expf(ce);
#ifdef EXP_QH4B
        { const unsigned n01 = __shfl_xor(qh01, 1), n23 = __shfl_xor(qh23, 1);
          if ((l15 & 1) == 0) { unsigned* qo = (unsigned*)(QH + (size_t)(16 * i) * 512);
            qo[0] = (qh01 & 0xffffu) | (n01 << 16); qo[256] = (qh01 >> 16) | (n01 & 0xffff0000u); qo[512] = (qh23 & 0xffffu) | (n23 << 16); qo[768] = (qh23 >> 16) | (n23 & 0xffff0000u); } }
#else
#ifdef QH_LDS
        if (i < 8) { LAS unsigned short* ql = (LAS unsigned short*)(lds + QLDS_OFF + (16 * i + 4 * tg) * QLDS_ROW) + k;
            ql[0] = (unsigned short)qh01; ql[QLDS_ROW / 2] = (unsigned short)(qh01 >> 16); ql[QLDS_ROW] = (unsigned short)qh23; ql[3 * QLDS_ROW / 2] = (unsigned short)(qh23 >> 16); }
        else
#endif
        { bf16* qo = QH + (size_t)(16 * i) * 512; qo[0] = (bf16)qh01; qo[512] = (bf16)(qh01 >> 16); qo[1024] = (bf16)qh23; qo[1536] = (bf16)(qh23 >> 16); }
#endif
        gacc += ce;
        __syncthreads();
        f32x4 at = {0.f, 0.f, 0.f, 0.f};
#pragma unroll
        for (int kq = 0; kq < 4; ++kq) {
            const s16x8 ka = *(const LAS s16x8*)(buf + H1_KP + (l15 * 136 + quad * 8 + 32 * kq) * 2);
            const s16x8 qb = *(const LAS s16x8*)(buf + H1_QT + (l15 * 136 + quad * 8 + 32 * kq) * 2);
            at = MFMA32(ka, qb, at);
        }
#pragma unroll
        for (int j = 0; j < 4; ++j) if (quad * 4 + j > l15) at[j] = 0.f;
        const u32x2 ptu = {pk2(at[0], at[1]), pk2(at[2], at[3])};
        const s16x4 pt = __builtin_bit_cast(s16x4, ptu);
        const s16x4 vf = *(const LAS s16x4*)(buf + H1_VT + ((16 * wave + l15) * H1_TROW + quad * 4) * 2);
        f32x4 o = {0.f, 0.f, 0.f, 0.f};
#pragma unroll
        for (int kq = 0; kq < 4; ++kq) {
            const u32x4 sau = {pk2(S[2 * kq][0], S[2 * kq][1]), pk2(S[2 * kq][2], S[2 * kq][3]), pk2(S[2 * kq + 1][0], S[2 * kq + 1][1]), pk2(S[2 * kq + 1][2], S[2 * kq + 1][3])};
            const s16x8 sa = __builtin_bit_cast(s16x8, sau);
            const u32x2 q0 = *(const LAS u32x2*)(buf + H1_QT + (l15 * 136 + 32 * kq + quad * 4) * 2);
            const u32x2 q1 = *(const LAS u32x2*)(buf + H1_QT + (l15 * 136 + 32 * kq + 16 + quad * 4) * 2);
            const u32x4 qbu = {q0.x, q0.y, q1.x, q1.y};
            o = MFMA32(sa, __builtin_bit_cast(s16x8, qbu), o);
        }
        MFMA_DRAIN();
        o = MFMA16(vf, pt, o);
#ifdef OL_LDS
        *(LAS u32x2*)(lds + OLDS_OFF + (16 * i + l15) * OLDS_ROW + (16 * wave + quad * 4) * 2) = (u32x2){pk2(o[0], o[1]), pk2(o[2], o[3])};
#else
        *(u32x2*)((bf16*)(a.ws + WS_OL) + (row0 + 16 * i + l15) * 512 + h * 128 + 16 * wave + quad * 4) = (u32x2){pk2(o[0], o[1]), pk2(o[2], o[3])};
#endif
#pragma unroll
        for (int kt = 0; kt < 8; ++kt) {
            const f32x4 d = *(const LAS f32x4*)(buf + H1_DS + (16 * kt + quad * 4) * 4);
            const s16x4 ka = *(const LAS s16x4*)(buf + H1_KBT + ((16 * kt + l15) * H1_TROW + quad * 4) * 2);
            S[kt] = MFMA16(ka, vf, S[kt] * d);
        }
#ifdef H1_TWO_BARRIERS
        __syncthreads();
#endif
    }
    float* L = (float*)(a.ws + WS_L) + (size_t)((b * HGH + h) * NSC + sc) * 16384;
#pragma unroll
    for (int kt = 0; kt < 8; ++kt) *(f32x4*)(L + (16 * wave + l15) * 128 + 16 * kt + quad * 4) = S[kt];
    if (tg == 0) ((float*)(a.ws + WS_D))[((b * HGH + h) * NSC + sc) * 128 + k] = __expf(gacc);
    __syncthreads();
}

#else
#ifdef HG1_FIX
constexpr int H1_G = 0, H1_QT = 8192, H1_KP = H1_QT + 4352, H1_KBT = H1_KP + 4352, H1_VT = H1_KBT + 5120, H1_DS = H1_VT + 5120, H1_BUF = H1_DS + 512, H1_TROW = 20;
__device__ __forceinline__ void hg_pass1(const Args& a, int layer, int unit, LAS unsigned char* lds) {
    int tid_ = threadIdx.x; asm volatile("" : "+v"(tid_)); const int tid = tid_, lane = tid & 63, wave = tid >> 6, l15 = lane & 15, quad = lane >> 4;
    const int b = unit / (HGH * NSC), h = (unit / NSC) % HGH, sc = unit % NSC;
    const int nsub = (sc == NSC - 1) ? 17 : 16;
    const int tok = tid >> 5, k4 = (tid & 31) * 4;
    bf16* P = (bf16*)(a.ws + WS_P);
    const float* lbp = (const float*)(a.ws + WS_LB) + layer * 512 + h * 128 + k4;
    const float lb[4] = {lbp[0], lbp[1], lbp[2], lbp[3]};
    const size_t row0 = (size_t)b * LP + (size_t)sc * 256;
    float gacc[4] = {0.f, 0.f, 0.f, 0.f};
    f32x4 S[8];
#pragma unroll
    for (int kt = 0; kt < 8; ++kt) S[kt] = (f32x4){0.f, 0.f, 0.f, 0.f};
    u32x2 zn, qn, vn;
    { const bf16* pn = P + (row0 + tok) * PW + h * 128 + k4; zn = __builtin_nontemporal_load((const u32x2*)(pn + C_FH)); qn = __builtin_nontemporal_load((const u32x2*)(pn + C_QH)); vn = __builtin_nontemporal_load((const u32x2*)(pn + C_IH)); }
    for (int i = 0; i < nsub; ++i) {
        LAS unsigned char* buf = lds + (i & 1) * H1_BUF;
        const u32x2 zz = zn, qq = qn, vv = vn;
        if (i + 1 < nsub) { const bf16* pn = P + (row0 + 16 * (i + 1) + tok) * PW + h * 128 + k4; zn = __builtin_nontemporal_load((const u32x2*)(pn + C_FH)); qn = __builtin_nontemporal_load((const u32x2*)(pn + C_QH)); vn = __builtin_nontemporal_load((const u32x2*)(pn + C_IH)); }
        const float z[4] = {bflo(zz.x), bfhi(zz.x), bflo(zz.y), bfhi(zz.y)}, q[4] = {bflo(qq.x), bfhi(qq.x), bflo(qq.y), bfhi(qq.y)};
        float g[4], kk[4], qs[4];
#pragma unroll
        for (int e = 0; e < 4; ++e) {
            const float sig = __builtin_amdgcn_rcpf(1.f + __expf(-z[e])), sigm = __builtin_amdgcn_rcpf(1.f + __expf(z[e]));
            const float f = lb[e] + (1.f - lb[e]) * sig;
            g[e] = __logf(fmaxf(f, 1e-30f)); kk[e] = (1.f - lb[e]) * sigm; qs[e] = silu_f(q[e]);
        }
        *(LAS f32x4*)(buf + H1_G + (tok * 128 + k4) * 4) = (f32x4){g[0], g[1], g[2], g[3]};
        __syncthreads();
        f32x4 ct = {0.f, 0.f, 0.f, 0.f}, ce = {0.f, 0.f, 0.f, 0.f};
#pragma unroll
        for (int u = 0; u < 16; ++u) { const f32x4 gu = *(const LAS f32x4*)(buf + H1_G + (u * 128 + k4) * 4); ce += gu; if (u <= tok) ct += gu; }
        float qt[4], kp[4], kb[4], qh[4];
#pragma unroll
        for (int e = 0; e < 4; ++e) {
            qt[e] = qs[e] * __expf(ct[e]); kp[e] = kk[e] * __expf(fminf(-ct[e], 80.f)); kb[e] = kk[e] * __expf(ce[e] - ct[e]); qh[e] = qs[e] * __expf(gacc[e] + ct[e]);
        }
        *(LAS u32x2*)(buf + H1_QT + (tok * 136 + k4) * 2) = (u32x2){pk2(qt[0], qt[1]), pk2(qt[2], qt[3])};
        *(LAS u32x2*)(buf + H1_KP + (tok * 136 + k4) * 2) = (u32x2){pk2(kp[0], kp[1]), pk2(kp[2], kp[3])};
        const unsigned short vraw[4] = {(unsigned short)(vv.x & 0xffffu), (unsigned short)(vv.x >> 16), (unsigned short)(vv.y & 0xffffu), (unsigned short)(vv.y >> 16)};
#pragma unroll
        for (int e = 0; e < 4; ++e) {
            *(LAS unsigned short*)(buf + H1_KBT + ((k4 + e) * H1_TROW + tok) * 2) = (unsigned short)(pk2(kb[e], kb[e]));
            *(LAS unsigned short*)(buf + H1_VT + ((k4 + e) * H1_TROW + tok) * 2) = vraw[e];
        }
        if (tok == 0) *(LAS f32x4*)(buf + H1_DS + k4 * 4) = (f32x4){__expf(ce[0]), __expf(ce[1]), __expf(ce[2]), __expf(ce[3])};
#ifdef EXP_QH2B
        { bf16* qo = (bf16*)(a.ws + WS_QH) + (row0 + 16 * i + tok) * 512 + h * 128 + k4; const unsigned w0 = pk2(qh[0], qh[1]), w1 = pk2(qh[2], qh[3]);
          qo[0] = (bf16)w0; qo[1] = (bf16)(w0 >> 16); qo[2] = (bf16)w1; qo[3] = (bf16)(w1 >> 16); }
#else
        *(u32x2*)((bf16*)(a.ws + WS_QH) + (row0 + 16 * i + tok) * 512 + h * 128 + k4) = (u32x2){pk2(qh[0], qh[1]), pk2(qh[2], qh[3])};
#endif
#pragma unroll
        for (int e = 0; e < 4; ++e) gacc[e] += ce[e];
        __syncthreads();
        f32x4 at = {0.f, 0.f, 0.f, 0.f};
#pragma unroll
        for (int kq = 0; kq < 4; ++kq) {
            const s16x8 ka = *(const LAS s16x8*)(buf + H1_KP + (l15 * 136 + quad * 8 + 32 * kq) * 2);
            const s16x8 qb = *(const LAS s16x8*)(buf + H1_QT + (l15 * 136 + quad * 8 + 32 * kq) * 2);
            at = MFMA32(ka, qb, at);
        }
        MFMA_DRAIN();
#pragma unroll
        for (int j = 0; j < 4; ++j) if (quad * 4 + j > l15) at[j] = 0.f;
        const u32x2 ptu = {pk2(at[0], at[1]), pk2(at[2], at[3])};
        const s16x4 pt = __builtin_bit_cast(s16x4, ptu);
        CVT_GAP();
        const s16x4 vf = *(const LAS s16x4*)(buf + H1_VT + ((16 * wave + l15) * H1_TROW + quad * 4) * 2);
        f32x4 o = {0.f, 0.f, 0.f, 0.f};
#pragma unroll
        for (int kq = 0; kq < 4; ++kq) {
            const u32x4 sau = {pk2(S[2 * kq][0], S[2 * kq][1]), pk2(S[2 * kq][2], S[2 * kq][3]), pk2(S[2 * kq + 1][0], S[2 * kq + 1][1]), pk2(S[2 * kq + 1][2], S[2 * kq + 1][3])};
            const s16x8 sa = __builtin_bit_cast(s16x8, sau);
            CVT_GAP();
            const s16x4 q0 = *(const LAS s16x4*)(buf + H1_QT + (l15 * 136 + 32 * kq + quad * 4) * 2);
            const s16x4 q1 = *(const LAS s16x4*)(buf + H1_QT + (l15 * 136 + 32 * kq + 16 + quad * 4) * 2);
            s16x8 qb; qb[0] = q0[0]; qb[1] = q0[1]; qb[2] = q0[2]; qb[3] = q0[3]; qb[4] = q1[0]; qb[5] = q1[1]; qb[6] = q1[2]; qb[7] = q1[3];
            o = MFMA32(sa, qb, o);
        }
        MFMA_DRAIN();
        o = MFMA16(vf, pt, o);
        MFMA_DRAIN();
        *(u32x2*)((bf16*)(a.ws + WS_OL) + (row0 + 16 * i + l15) * 512 + h * 128 + 16 * wave + quad * 4) = (u32x2){pk2(o[0], o[1]), pk2(o[2], o[3])};
#pragma unroll
        for (int kt = 0; kt < 8; ++kt) {
            const f32x4 d = *(const LAS f32x4*)(buf + H1_DS + (16 * kt + quad * 4) * 4);
            const s16x4 ka = *(const LAS s16x4*)(buf + H1_KBT + ((16 * kt + l15) * H1_TROW + quad * 4) * 2);
            S[kt] = MFMA16(ka, vf, S[kt] * d);
        }
    }
    float* L = (float*)(a.ws + WS_L) + (size_t)((b * HGH + h) * NSC + sc) * 16384;
#pragma unroll
    for (int kt = 0; kt < 8; ++kt) *(f32x4*)(L + (16 * wave + l15) * 128 + 16 * kt + quad * 4) = S[kt];
    if (tok == 0) { float* D = (float*)(a.ws + WS_D) + ((b * HGH + h) * NSC + sc) * 128 + k4;
        *(f32x4*)D = (f32x4){__expf(gacc[0]), __expf(gacc[1]), __expf(gacc[2]), __expf(gacc[3])}; }
    __syncthreads();
}

#elif defined(HG1_SW)
constexpr int H1_G = 0, H1_QT = 8192, H1_KP = H1_QT + 4352, H1_KBT = H1_KP + 4352, H1_VT = H1_KBT + 5120, H1_DS = H1_VT + 5120, H1_BUF = H1_DS + 512, H1_TROW = 20;
__device__ __forceinline__ void hg_pass1(const Args& a, int layer, int unit, LAS unsigned char* lds) {
    int tid_ = threadIdx.x; asm volatile("" : "+v"(tid_)); const int tid = tid_, lane = tid & 63, wave = tid >> 6, l15 = lane & 15, quad = lane >> 4;
    const int b = unit / (HGH * NSC), h = (unit / NSC) % HGH, sc = unit % NSC;
    const int nsub = (sc == NSC - 1) ? 17 : 16;
    const int tok = tid >> 5, k4 = (tid & 31) * 4;
    bf16* P = (bf16*)(a.ws + WS_P);
    const float* lbp = (const float*)(a.ws + WS_LB) + layer * 512 + h * 128 + k4;
    const float lb[4] = {lbp[0], lbp[1], lbp[2], lbp[3]};
    const size_t row0 = (size_t)b * LP + (size_t)sc * 256;
    float gacc[4] = {0.f, 0.f, 0.f, 0.f};
    f32x4 S[8];
#pragma unroll
    for (int kt = 0; kt < 8; ++kt) S[kt] = (f32x4){0.f, 0.f, 0.f, 0.f};
    u32x2 zn, qn, vn;
    { const bf16* pn = P + (row0 + tok) * PW + h * 128 + k4; zn = __builtin_nontemporal_load((const u32x2*)(pn + C_FH)); qn = __builtin_nontemporal_load((const u32x2*)(pn + C_QH)); vn = __builtin_nontemporal_load((const u32x2*)(pn + C_IH)); }
    for (int i = 0; i < nsub; ++i) {
        LAS unsigned char* buf = lds + (i & 1) * H1_BUF;
        const u32x2 zz = zn, qq = qn, vv = vn;
        if (i + 1 < nsub) { const bf16* pn = P + (row0 + 16 * (i + 1) + tok) * PW + h * 128 + k4; zn = __builtin_nontemporal_load((const u32x2*)(pn + C_FH)); qn = __builtin_nontemporal_load((const u32x2*)(pn + C_QH)); vn = __builtin_nontemporal_load((const u32x2*)(pn + C_IH)); }
        const float z[4] = {bflo(zz.x), bfhi(zz.x), bflo(zz.y), bfhi(zz.y)}, q[4] = {bflo(qq.x), bfhi(qq.x), bflo(qq.y), bfhi(qq.y)};
        float g[4], kk[4], qs[4];
#pragma unroll
        for (int e = 0; e < 4; ++e) {
            const float sig = __builtin_amdgcn_rcpf(1.f + __expf(-z[e])), sigm = __builtin_amdgcn_rcpf(1.f + __expf(z[e]));
            const float f = lb[e] + (1.f - lb[e]) * sig;
            g[e] = __logf(fmaxf(f, 1e-30f)); kk[e] = (1.f - lb[e]) * sigm; qs[e] = silu_f(q[e]);
        }
        *(LAS f32x4*)(buf + H1_G + (tok * 128 + k4) * 4) = (f32x4){g[0], g[1], g[2], g[3]};
        __syncthreads();
        f32x4 ct = {0.f, 0.f, 0.f, 0.f}, ce = {0.f, 0.f, 0.f, 0.f};
#pragma unroll
        for (int u = 0; u < 16; ++u) { const f32x4 gu = *(const LAS f32x4*)(buf + H1_G + (u * 128 + k4) * 4); ce += gu; if (u <= tok) ct += gu; }
        float qt[4], kp[4], kb[4], qh[4];
#pragma unroll
        for (int e = 0; e < 4; ++e) {
            qt[e] = qs[e] * __expf(ct[e]); kp[e] = kk[e] * __expf(fminf(-ct[e], 80.f)); kb[e] = kk[e] * __expf(ce[e] - ct[e]); qh[e] = qs[e] * __expf(gacc[e] + ct[e]);
        }
        *(LAS u32x2*)(buf + H1_QT + (tok * 136 + k4) * 2) = (u32x2){pk2(qt[0], qt[1]), pk2(qt[2], qt[3])};
        *(LAS u32x2*)(buf + H1_KP + (tok * 136 + k4) * 2) = (u32x2){pk2(kp[0], kp[1]), pk2(kp[2], kp[3])};
        const unsigned short vraw[4] = {(unsigned short)(vv.x & 0xffffu), (unsigned short)(vv.x >> 16), (unsigned short)(vv.y & 0xffffu), (unsigned short)(vv.y >> 16)};
#pragma unroll
        for (int e = 0; e < 4; ++e) {
            *(LAS unsigned short*)(buf + H1_KBT + ((k4 + e) * H1_TROW + tok) * 2) = (unsigned short)((__builtin_bit_cast(unsigned, kb[e]) + 0x8000u) >> 16);
            *(LAS unsigned short*)(buf + H1_VT + ((k4 + e) * H1_TROW + tok) * 2) = vraw[e];
        }
        if (tok == 0) *(LAS f32x4*)(buf + H1_DS + k4 * 4) = (f32x4){__expf(ce[0]), __expf(ce[1]), __expf(ce[2]), __expf(ce[3])};
        *(u32x2*)((bf16*)(a.ws + WS_QH) + (row0 + 16 * i + tok) * 512 + h * 128 + k4) = (u32x2){pk2(qh[0], qh[1]), pk2(qh[2], qh[3])};
#pragma unroll
        for (int e = 0; e < 4; ++e) gacc[e] += ce[e];
        __syncthreads();
        f32x4 at = zero_acc();
#pragma unroll
        for (int kq = 0; kq < 4; ++kq) {
            const s16x8 ka = *(const LAS s16x8*)(buf + H1_KP + (l15 * 136 + quad * 8 + 32 * kq) * 2);
            const s16x8 qb = *(const LAS s16x8*)(buf + H1_QT + (l15 * 136 + quad * 8 + 32 * kq) * 2);
            at = MFMA32(ka, qb, at);
        }
#pragma unroll
        for (int j = 0; j < 4; ++j) if (quad * 4 + j > l15) at[j] = 0.f;
        const u32x2 ptu = {pk2s(at[0], at[1]), pk2s(at[2], at[3])};
        const s16x4 pt = __builtin_bit_cast(s16x4, ptu);
        const s16x4 vf = *(const LAS s16x4*)(buf + H1_VT + ((16 * wave + l15) * H1_TROW + quad * 4) * 2);
        f32x4 o = zero_acc();
#pragma unroll
        for (int kq = 0; kq < 4; ++kq) {
            const u32x4 sau = {pk2s(S[2 * kq][0], S[2 * kq][1]), pk2s(S[2 * kq][2], S[2 * kq][3]), pk2s(S[2 * kq + 1][0], S[2 * kq + 1][1]), pk2s(S[2 * kq + 1][2], S[2 * kq + 1][3])};
            const s16x8 sa = __builtin_bit_cast(s16x8, sau);
            const s16x4 q0 = *(const LAS s16x4*)(buf + H1_QT + (l15 * 136 + 32 * kq + quad * 4) * 2);
            const s16x4 q1 = *(const LAS s16x4*)(buf + H1_QT + (l15 * 136 + 32 * kq + 16 + quad * 4) * 2);
            s16x8 qb; qb[0] = q0[0]; qb[1] = q0[1]; qb[2] = q0[2]; qb[3] = q0[3]; qb[4] = q1[0]; qb[5] = q1[1]; qb[6] = q1[2]; qb[7] = q1[3];
            o = MFMA32(sa, qb, o);
        }
        MFMA_DRAIN();
        o = MFMA16(vf, pt, o);
        *(u32x2*)((bf16*)(a.ws + WS_OL) + (row0 + 16 * i + l15) * 512 + h * 128 + 16 * wave + quad * 4) = (u32x2){pk2(o[0], o[1]), pk2(o[2], o[3])};
#pragma unroll
        for (int kt = 0; kt < 8; ++kt) {
            const f32x4 d = *(const LAS f32x4*)(buf + H1_DS + (16 * kt + quad * 4) * 4);
            const s16x4 ka = *(const LAS s16x4*)(buf + H1_KBT + ((16 * kt + l15) * H1_TROW + quad * 4) * 2);
            S[kt] = MFMA16(ka, vf, S[kt] * d);
        }
    }
    float* L = (float*)(a.ws + WS_L) + (size_t)((b * HGH + h) * NSC + sc) * 16384;
#pragma unroll
    for (int kt = 0; kt < 8; ++kt) *(f32x4*)(L + (16 * wave + l15) * 128 + 16 * kt + quad * 4) = S[kt];
    if (tok == 0) { float* D = (float*)(a.ws + WS_D) + ((b * HGH + h) * NSC + sc) * 128 + k4;
        *(f32x4*)D = (f32x4){__expf(gacc[0]), __expf(gacc[1]), __expf(gacc[2]), __expf(gacc[3])}; }
    __syncthreads();
}

#elif defined(HG1_RCP)
constexpr int H1_G = 0, H1_QT = 8192, H1_KP = H1_QT + 4352, H1_KBT = H1_KP + 4352, H1_VT = H1_KBT + 5120, H1_DS = H1_VT + 5120, H1_BUF = H1_DS + 512, H1_TROW = 20;
__device__ __forceinline__ void hg_pass1(const Args& a, int layer, int unit, LAS unsigned char* lds) {
    int tid_ = threadIdx.x; asm volatile("" : "+v"(tid_)); const int tid = tid_, lane = tid & 63, wave = tid >> 6, l15 = lane & 15, quad = lane >> 4;
    const int b = unit / (HGH * NSC), h = (unit / NSC) % HGH, sc = unit % NSC;
    const int nsub = (sc == NSC - 1) ? 17 : 16;
    const int tok = tid >> 5, k4 = (tid & 31) * 4;
    bf16* P = (bf16*)(a.ws + WS_P);
    const float* lbp = (const float*)(a.ws + WS_LB) + layer * 512 + h * 128 + k4;
    const float lb[4] = {lbp[0], lbp[1], lbp[2], lbp[3]};
    const size_t row0 = (size_t)b * LP + (size_t)sc * 256;
    float gacc[4] = {0.f, 0.f, 0.f, 0.f};
    f32x4 S[8];
#pragma unroll
    for (int kt = 0; kt < 8; ++kt) S[kt] = (f32x4){0.f, 0.f, 0.f, 0.f};
    u32x2 zn, qn, vn;
    { const bf16* pn = P + (row0 + tok) * PW + h * 128 + k4; zn = __builtin_nontemporal_load((const u32x2*)(pn + C_FH)); qn = __builtin_nontemporal_load((const u32x2*)(pn + C_QH)); vn = __builtin_nontemporal_load((const u32x2*)(pn + C_IH)); }
    for (int i = 0; i < nsub; ++i) {
        LAS unsigned char* buf = lds + (i & 1) * H1_BUF;
        const u32x2 zz = zn, qq = qn, vv = vn;
        if (i + 1 < nsub) { const bf16* pn = P + (row0 + 16 * (i + 1) + tok) * PW + h * 128 + k4; zn = __builtin_nontemporal_load((const u32x2*)(pn + C_FH)); qn = __builtin_nontemporal_load((const u32x2*)(pn + C_QH)); vn = __builtin_nontemporal_load((const u32x2*)(pn + C_IH)); }
        const float z[4] = {bflo(zz.x), bfhi(zz.x), bflo(zz.y), bfhi(zz.y)}, q[4] = {bflo(qq.x), bfhi(qq.x), bflo(qq.y), bfhi(qq.y)};
        float g[4], kk[4], qs[4];
#pragma unroll
        for (int e = 0; e < 4; ++e) {
            const float sig = __builtin_amdgcn_rcpf(1.f + __expf(-z[e])), sigm = __builtin_amdgcn_rcpf(1.f + __expf(z[e]));
            const float f = lb[e] + (1.f - lb[e]) * sig;
            g[e] = __logf(fmaxf(f, 1e-30f)); kk[e] = (1.f - lb[e]) * sigm; qs[e] = silu_f(q[e]);
        }
        *(LAS f32x4*)(buf + H1_G + (tok * 128 + k4) * 4) = (f32x4){g[0], g[1], g[2], g[3]};
        __syncthreads();
        f32x4 ct = {0.f, 0.f, 0.f, 0.f}, ce = {0.f, 0.f, 0.f, 0.f};
#pragma unroll
        for (int u = 0; u < 16; ++u) { const f32x4 gu = *(const LAS f32x4*)(buf + H1_G + (u * 128 + k4) * 4); ce += gu; if (u <= tok) ct += gu; }
        float qt[4], kp[4], kb[4], qh[4];
#pragma unroll
        for (int e = 0; e < 4; ++e) {
            qt[e] = qs[e] * __expf(ct[e]); kp[e] = kk[e] * __expf(fminf(-ct[e], 80.f)); kb[e] = kk[e] * __expf(ce[e] - ct[e]); qh[e] = qs[e] * __expf(gacc[e] + ct[e]);
        }
        *(LAS u32x2*)(buf + H1_QT + (tok * 136 + k4) * 2) = (u32x2){pk2(qt[0], qt[1]), pk2(qt[2], qt[3])};
        *(LAS u32x2*)(buf + H1_KP + (tok * 136 + k4) * 2) = (u32x2){pk2(kp[0], kp[1]), pk2(kp[2], kp[3])};
        const unsigned short vraw[4] = {(unsigned short)(vv.x & 0xffffu), (unsigned short)(vv.x >> 16), (unsigned short)(vv.y & 0xffffu), (unsigned short)(vv.y >> 16)};
#pragma unroll
        for (int e = 0; e < 4; ++e) {
            *(LAS unsigned short*)(buf + H1_KBT + ((k4 + e) * H1_TROW + tok) * 2) = (unsigned short)f2bf(kb[e]);
            *(LAS unsigned short*)(buf + H1_VT + ((k4 + e) * H1_TROW + tok) * 2) = vraw[e];
        }
        if (tok == 0) *(LAS f32x4*)(buf + H1_DS + k4 * 4) = (f32x4){__expf(ce[0]), __expf(ce[1]), __expf(ce[2]), __expf(ce[3])};
        *(u32x2*)((bf16*)(a.ws + WS_QH) + (row0 + 16 * i + tok) * 512 + h * 128 + k4) = (u32x2){pk2(qh[0], qh[1]), pk2(qh[2], qh[3])};
#pragma unroll
        for (int e = 0; e < 4; ++e) gacc[e] += ce[e];
        __syncthreads();
        f32x4 at = {0.f, 0.f, 0.f, 0.f};
#pragma unroll
        for (int kq = 0; kq < 4; ++kq) {
            const s16x8 ka = *(const LAS s16x8*)(buf + H1_KP + (l15 * 136 + quad * 8 + 32 * kq) * 2);
            const s16x8 qb = *(const LAS s16x8*)(buf + H1_QT + (l15 * 136 + quad * 8 + 32 * kq) * 2);
            at = MFMA32(ka, qb, at);
        }
#pragma unroll
        for (int j = 0; j < 4; ++j) if (quad * 4 + j > l15) at[j] = 0.f;
        s16x4 pt; pt[0] = (short)f2bf(at[0]); pt[1] = (short)f2bf(at[1]); pt[2] = (short)f2bf(at[2]); pt[3] = (short)f2bf(at[3]);
        const s16x4 vf = *(const LAS s16x4*)(buf + H1_VT + ((16 * wave + l15) * H1_TROW + quad * 4) * 2);
        f32x4 o = {0.f, 0.f, 0.f, 0.f};
#pragma unroll
        for (int kq = 0; kq < 4; ++kq) {
            s16x8 sa;
#pragma unroll
            for (int j = 0; j < 4; ++j) { sa[j] = (short)f2bf(S[2 * kq][j]); sa[4 + j] = (short)f2bf(S[2 * kq + 1][j]); }
            const s16x4 q0 = *(const LAS s16x4*)(buf + H1_QT + (l15 * 136 + 32 * kq + quad * 4) * 2);
            const s16x4 q1 = *(const LAS s16x4*)(buf + H1_QT + (l15 * 136 + 32 * kq + 16 + quad * 4) * 2);
            s16x8 qb; qb[0] = q0[0]; qb[1] = q0[1]; qb[2] = q0[2]; qb[3] = q0[3]; qb[4] = q1[0]; qb[5] = q1[1]; qb[6] = q1[2]; qb[7] = q1[3];
            o = MFMA32(sa, qb, o);
        }
        MFMA_DRAIN();
        o = MFMA16(vf, pt, o);
        *(u32x2*)((bf16*)(a.ws + WS_OL) + (row0 + 16 * i + l15) * 512 + h * 128 + 16 * wave + quad * 4) = (u32x2){pk2(o[0], o[1]), pk2(o[2], o[3])};
#pragma unroll
        for (int kt = 0; kt < 8; ++kt) {
            const f32x4 d = *(const LAS f32x4*)(buf + H1_DS + (16 * kt + quad * 4) * 4);
            const s16x4 ka = *(const LAS s16x4*)(buf + H1_KBT + ((16 * kt + l15) * H1_TROW + quad * 4) * 2);
            S[kt] = MFMA16(ka, vf, S[kt] * d);
        }
    }
    float* L = (float*)(a.ws + WS_L) + (size_t)((b * HGH + h) * NSC + sc) * 16384;
#pragma unroll
    for (int kt = 0; kt < 8; ++kt) *(f32x4*)(L + (16 * wave + l15) * 128 + 16 * kt + quad * 4) = S[kt];
    if (tok == 0) { float* D = (float*)(a.ws + WS_D) + ((b * HGH + h) * NSC + sc) * 128 + k4;
        *(f32x4*)D = (f32x4){__expf(gacc[0]), __expf(gacc[1]), __expf(gacc[2]), __expf(gacc[3])}; }
    __syncthreads();
}

#elif defined(HG1_TROW)
constexpr int H1_G = 0, H1_QT = 8192, H1_KP = H1_QT + 4352, H1_KBT = H1_KP + 4352, H1_VT = H1_KBT + 5120, H1_DS = H1_VT + 5120, H1_BUF = H1_DS + 512, H1_TROW = 20;
__device__ __forceinline__ void hg_pass1(const Args& a, int layer, int unit, LAS unsigned char* lds) {
    int tid_ = threadIdx.x; asm volatile("" : "+v"(tid_)); const int tid = tid_, lane = tid & 63, wave = tid >> 6, l15 = lane & 15, quad = lane >> 4;
    const int b = unit / (HGH * NSC), h = (unit / NSC) % HGH, sc = unit % NSC;
    const int nsub = (sc == NSC - 1) ? 17 : 16;
    const int tok = tid >> 5, k4 = (tid & 31) * 4;
    bf16* P = (bf16*)(a.ws + WS_P);
    const float* lbp = (const float*)(a.ws + WS_LB) + layer * 512 + h * 128 + k4;
    const float lb[4] = {lbp[0], lbp[1], lbp[2], lbp[3]};
    const size_t row0 = (size_t)b * LP + (size_t)sc * 256;
    float gacc[4] = {0.f, 0.f, 0.f, 0.f};
    f32x4 S[8];
#pragma unroll
    for (int kt = 0; kt < 8; ++kt) S[kt] = (f32x4){0.f, 0.f, 0.f, 0.f};
    u32x2 zn, qn, vn;
    { const bf16* pn = P + (row0 + tok) * PW + h * 128 + k4; zn = __builtin_nontemporal_load((const u32x2*)(pn + C_FH)); qn = __builtin_nontemporal_load((const u32x2*)(pn + C_QH)); vn = __builtin_nontemporal_load((const u32x2*)(pn + C_IH)); }
    for (int i = 0; i < nsub; ++i) {
        LAS unsigned char* buf = lds + (i & 1) * H1_BUF;
        const u32x2 zz = zn, qq = qn, vv = vn;
        if (i + 1 < nsub) { const bf16* pn = P + (row0 + 16 * (i + 1) + tok) * PW + h * 128 + k4; zn = __builtin_nontemporal_load((const u32x2*)(pn + C_FH)); qn = __builtin_nontemporal_load((const u32x2*)(pn + C_QH)); vn = __builtin_nontemporal_load((const u32x2*)(pn + C_IH)); }
        const float z[4] = {bflo(zz.x), bfhi(zz.x), bflo(zz.y), bfhi(zz.y)}, q[4] = {bflo(qq.x), bfhi(qq.x), bflo(qq.y), bfhi(qq.y)};
        float g[4], kk[4], qs[4];
#pragma unroll
        for (int e = 0; e < 4; ++e) {
            const float sig = 1.f / (1.f + __expf(-z[e])), sigm = 1.f / (1.f + __expf(z[e]));
            const float f = lb[e] + (1.f - lb[e]) * sig;
            g[e] = __logf(fmaxf(f, 1e-30f)); kk[e] = (1.f - lb[e]) * sigm; qs[e] = silu_f(q[e]);
        }
        *(LAS f32x4*)(buf + H1_G + (tok * 128 + k4) * 4) = (f32x4){g[0], g[1], g[2], g[3]};
        __syncthreads();
        f32x4 ct = {0.f, 0.f, 0.f, 0.f}, ce = {0.f, 0.f, 0.f, 0.f};
#pragma unroll
        for (int u = 0; u < 16; ++u) { const f32x4 gu = *(const LAS f32x4*)(buf + H1_G + (u * 128 + k4) * 4); ce += gu; if (u <= tok) ct += gu; }
        float qt[4], kp[4], kb[4], qh[4];
#pragma unroll
        for (int e = 0; e < 4; ++e) {
            qt[e] = qs[e] * __expf(ct[e]); kp[e] = kk[e] * __expf(fminf(-ct[e], 80.f)); kb[e] = kk[e] * __expf(ce[e] - ct[e]); qh[e] = qs[e] * __expf(gacc[e] + ct[e]);
        }
        *(LAS u32x2*)(buf + H1_QT + (tok * 136 + k4) * 2) = (u32x2){pk2(qt[0], qt[1]), pk2(qt[2], qt[3])};
        *(LAS u32x2*)(buf + H1_KP + (tok * 136 + k4) * 2) = (u32x2){pk2(kp[0], kp[1]), pk2(kp[2], kp[3])};
        const unsigned short vraw[4] = {(unsigned short)(vv.x & 0xffffu), (unsigned short)(vv.x >> 16), (unsigned short)(vv.y & 0xffffu), (unsigned short)(vv.y >> 16)};
#pragma unroll
        for (int e = 0; e < 4; ++e) {
            *(LAS unsigned short*)(buf + H1_KBT + ((k4 + e) * H1_TROW + tok) * 2) = (unsigned short)f2bf(kb[e]);
            *(LAS unsigned short*)(buf + H1_VT + ((k4 + e) * H1_TROW + tok) * 2) = vraw[e];
        }
        if (tok == 0) *(LAS f32x4*)(buf + H1_DS + k4 * 4) = (f32x4){__expf(ce[0]), __expf(ce[1]), __expf(ce[2]), __expf(ce[3])};
        *(u32x2*)((bf16*)(a.ws + WS_QH) + (row0 + 16 * i + tok) * 512 + h * 128 + k4) = (u32x2){pk2(qh[0], qh[1]), pk2(qh[2], qh[3])};
#pragma unroll
        for (int e = 0; e < 4; ++e) gacc[e] += ce[e];
        __syncthreads();
        f32x4 at = {0.f, 0.f, 0.f, 0.f};
#pragma unroll
        for (int kq = 0; kq < 4; ++kq) {
            const s16x8 ka = *(const LAS s16x8*)(buf + H1_KP + (l15 * 136 + quad * 8 + 32 * kq) * 2);
            const s16x8 qb = *(const LAS s16x8*)(buf + H1_QT + (l15 * 136 + quad * 8 + 32 * kq) * 2);
            at = MFMA32(ka, qb, at);
        }
#pragma unroll
        for (int j = 0; j < 4; ++j) if (quad * 4 + j > l15) at[j] = 0.f;
        s16x4 pt; pt[0] = (short)f2bf(at[0]); pt[1] = (short)f2bf(at[1]); pt[2] = (short)f2bf(at[2]); pt[3] = (short)f2bf(at[3]);
        const s16x4 vf = *(const LAS s16x4*)(buf + H1_VT + ((16 * wave + l15) * H1_TROW + quad * 4) * 2);
        f32x4 o = {0.f, 0.f, 0.f, 0.f};
#pragma unroll
        for (int kq = 0; kq < 4; ++kq) {
            s16x8 sa;
#pragma unroll
            for (int j = 0; j < 4; ++j) { sa[j] = (short)f2bf(S[2 * kq][j]); sa[4 + j] = (short)f2bf(S[2 * kq + 1][j]); }
            const s16x4 q0 = *(const LAS s16x4*)(buf + H1_QT + (l15 * 136 + 32 * kq + quad * 4) * 2);
            const s16x4 q1 = *(const LAS s16x4*)(buf + H1_QT + (l15 * 136 + 32 * kq + 16 + quad * 4) * 2);
            s16x8 qb; qb[0] = q0[0]; qb[1] = q0[1]; qb[2] = q0[2]; qb[3] = q0[3]; qb[4] = q1[0]; qb[5] = q1[1]; qb[6] = q1[2]; qb[7] = q1[3];
            o = MFMA32(sa, qb, o);
        }
        MFMA_DRAIN();
        o = MFMA16(vf, pt, o);
        *(u32x2*)((bf16*)(a.ws + WS_OL) + (row0 + 16 * i + l15) * 512 + h * 128 + 16 * wave + quad * 4) = (u32x2){pk2(o[0], o[1]), pk2(o[2], o[3])};
#pragma unroll
        for (int kt = 0; kt < 8; ++kt) {
            const f32x4 d = *(const LAS f32x4*)(buf + H1_DS + (16 * kt + quad * 4) * 4);
            const s16x4 ka = *(const LAS s16x4*)(buf + H1_KBT + ((16 * kt + l15) * H1_TROW + quad * 4) * 2);
            S[kt] = MFMA16(ka, vf, S[kt] * d);
        }
    }
    float* L = (float*)(a.ws + WS_L) + (size_t)((b * HGH + h) * NSC + sc) * 16384;
#pragma unroll
    for (int kt = 0; kt < 8; ++kt) *(f32x4*)(L + (16 * wave + l15) * 128 + 16 * kt + quad * 4) = S[kt];
    if (tok == 0) { float* D = (float*)(a.ws + WS_D) + ((b * HGH + h) * NSC + sc) * 128 + k4;
        *(f32x4*)D = (f32x4){__expf(gacc[0]), __expf(gacc[1]), __expf(gacc[2]), __expf(gacc[3])}; }
    __syncthreads();
}

#else
constexpr int H1_G = 0, H1_QT = 8192, H1_KP = H1_QT + 4352, H1_KBT = H1_KP + 4352, H1_VT = H1_KBT + 4096, H1_DS = H1_VT + 4096, H1_BUF = H1_DS + 512;
__device__ __forceinline__ void hg_pass1(const Args& a, int layer, int unit, LAS unsigned char* lds) {
    int tid_ = threadIdx.x; asm volatile("" : "+v"(tid_)); const int tid = tid_, lane = tid & 63, wave = tid >> 6, l15 = lane & 15, quad = lane >> 4;
    const int b = unit / (HGH * NSC), h = (unit / NSC) % HGH, sc = unit % NSC;
    const int nsub = (sc == NSC - 1) ? 17 : 16;
    const int tok = tid >> 5, k4 = (tid & 31) * 4;
    bf16* P = (bf16*)(a.ws + WS_P);
    const float* lbp = (const float*)(a.ws + WS_LB) + layer * 512 + h * 128 + k4;
    const float lb[4] = {lbp[0], lbp[1], lbp[2], lbp[3]};
    const size_t row0 = (size_t)b * LP + (size_t)sc * 256;
    float gacc[4] = {0.f, 0.f, 0.f, 0.f};
    f32x4 S[8];
#pragma unroll
    for (int kt = 0; kt < 8; ++kt) S[kt] = (f32x4){0.f, 0.f, 0.f, 0.f};
    u32x2 zn, qn, vn;
    { const bf16* pn = P + (row0 + tok) * PW + h * 128 + k4; zn = __builtin_nontemporal_load((const u32x2*)(pn + C_FH)); qn = __builtin_nontemporal_load((const u32x2*)(pn + C_QH)); vn = __builtin_nontemporal_load((const u32x2*)(pn + C_IH)); }
    for (int i = 0; i < nsub; ++i) {
        LAS unsigned char* buf = lds + (i & 1) * H1_BUF;
        const u32x2 zz = zn, qq = qn, vv = vn;
        if (i + 1 < nsub) { const bf16* pn = P + (row0 + 16 * (i + 1) + tok) * PW + h * 128 + k4; zn = __builtin_nontemporal_load((const u32x2*)(pn + C_FH)); qn = __builtin_nontemporal_load((const u32x2*)(pn + C_QH)); vn = __builtin_nontemporal_load((const u32x2*)(pn + C_IH)); }
        const float z[4] = {bflo(zz.x), bfhi(zz.x), bflo(zz.y), bfhi(zz.y)}, q[4] = {bflo(qq.x), bfhi(qq.x), bflo(qq.y), bfhi(qq.y)};
        float g[4], kk[4], qs[4];
#pragma unroll
        for (int e = 0; e < 4; ++e) {
            const float sig = 1.f / (1.f + __expf(-z[e])), sigm = 1.f / (1.f + __expf(z[e]));
            const float f = lb[e] + (1.f - lb[e]) * sig;
            g[e] = __logf(fmaxf(f, 1e-30f)); kk[e] = (1.f - lb[e]) * sigm; qs[e] = silu_f(q[e]);
        }
        *(LAS f32x4*)(buf + H1_G + (tok * 128 + k4) * 4) = (f32x4){g[0], g[1], g[2], g[3]};
        __syncthreads();
        f32x4 ct = {0.f, 0.f, 0.f, 0.f}, ce = {0.f, 0.f, 0.f, 0.f};
#pragma unroll
        for (int u = 0; u < 16; ++u) { const f32x4 gu = *(const LAS f32x4*)(buf + H1_G + (u * 128 + k4) * 4); ce += gu; if (u <= tok) ct += gu; }
        float qt[4], kp[4], kb[4], qh[4];
#pragma unroll
        for (int e = 0; e < 4; ++e) {
            qt[e] = qs[e] * __expf(ct[e]); kp[e] = kk[e] * __expf(fminf(-ct[e], 80.f)); kb[e] = kk[e] * __expf(ce[e] - ct[e]); qh[e] = qs[e] * __expf(gacc[e] + ct[e]);
        }
        *(LAS u32x2*)(buf + H1_QT + (tok * 136 + k4) * 2) = (u32x2){pk2(qt[0], qt[1]), pk2(qt[2], qt[3])};
        *(LAS u32x2*)(buf + H1_KP + (tok * 136 + k4) * 2) = (u32x2){pk2(kp[0], kp[1]), pk2(kp[2], kp[3])};
        const unsigned short vraw[4] = {(unsigned short)(vv.x & 0xffffu), (unsigned short)(vv.x >> 16), (unsigned short)(vv.y & 0xffffu), (unsigned short)(vv.y >> 16)};
#pragma unroll
        for (int e = 0; e < 4; ++e) {
            *(LAS unsigned short*)(buf + H1_KBT + ((k4 + e) * 16 + tok) * 2) = (unsigned short)f2bf(kb[e]);
            *(LAS unsigned short*)(buf + H1_VT + ((k4 + e) * 16 + tok) * 2) = vraw[e];
        }
        if (tok == 0) *(LAS f32x4*)(buf + H1_DS + k4 * 4) = (f32x4){__expf(ce[0]), __expf(ce[1]), __expf(ce[2]), __expf(ce[3])};
        *(u32x2*)((bf16*)(a.ws + WS_QH) + (row0 + 16 * i + tok) * 512 + h * 128 + k4) = (u32x2){pk2(qh[0], qh[1]), pk2(qh[2], qh[3])};
#pragma unroll
        for (int e = 0; e < 4; ++e) gacc[e] += ce[e];
        __syncthreads();
        f32x4 at = {0.f, 0.f, 0.f, 0.f};
#pragma unroll
        for (int kq = 0; kq < 4; ++kq) {
            const s16x8 ka = *(const LAS s16x8*)(buf + H1_KP + (l15 * 136 + quad * 8 + 32 * kq) * 2);
            const s16x8 qb = *(const LAS s16x8*)(buf + H1_QT + (l15 * 136 + quad * 8 + 32 * kq) * 2);
            at = MFMA32(ka, qb, at);
        }
#pragma unroll
        for (int j = 0; j < 4; ++j) if (quad * 4 + j > l15) at[j] = 0.f;
        s16x4 pt; pt[0] = (short)f2bf(at[0]); pt[1] = (short)f2bf(at[1]); pt[2] = (short)f2bf(at[2]); pt[3] = (short)f2bf(at[3]);
        const s16x4 vf = *(const LAS s16x4*)(buf + H1_VT + ((16 * wave + l15) * 16 + quad * 4) * 2);
        f32x4 o = {0.f, 0.f, 0.f, 0.f};
#pragma unroll
        for (int kq = 0; kq < 4; ++kq) {
            s16x8 sa;
#pragma unroll
            for (int j = 0; j < 4; ++j) { sa[j] = (short)f2bf(S[2 * kq][j]); sa[4 + j] = (short)f2bf(S[2 * kq + 1][j]); }
            const s16x4 q0 = *(const LAS s16x4*)(buf + H1_QT + (l15 * 136 + 32 * kq + quad * 4) * 2);
            const s16x4 q1 = *(const LAS s16x4*)(buf + H1_QT + (l15 * 136 + 32 * kq + 16 + quad * 4) * 2);
            s16x8 qb; qb[0] = q0[0]; qb[1] = q0[1]; qb[2] = q0[2]; qb[3] = q0[3]; qb[4] = q1[0]; qb[5] = q1[1]; qb[6] = q1[2]; qb[7] = q1[3];
            o = MFMA32(sa, qb, o);
        }
        MFMA_DRAIN();
        o = MFMA16(vf, pt, o);
        *(u32x2*)((bf16*)(a.ws + WS_OL) + (row0 + 16 * i + l15) * 512 + h * 128 + 16 * wave + quad * 4) = (u32x2){pk2(o[0], o[1]), pk2(o[2], o[3])};
#pragma unroll
        for (int kt = 0; kt < 8; ++kt) {
            const f32x4 d = *(const LAS f32x4*)(buf + H1_DS + (16 * kt + quad * 4) * 4);
            const s16x4 ka = *(const LAS s16x4*)(buf + H1_KBT + ((16 * kt + l15) * 16 + quad * 4) * 2);
            S[kt] = MFMA16(ka, vf, S[kt] * d);
        }
    }
    float* L = (float*)(a.ws + WS_L) + (size_t)((b * HGH + h) * NSC + sc) * 16384;
#pragma unroll
    for (int kt = 0; kt < 8; ++kt) *(f32x4*)(L + (16 * wave + l15) * 128 + 16 * kt + quad * 4) = S[kt];
    if (tok == 0) { float* D = (float*)(a.ws + WS_D) + ((b * HGH + h) * NSC + sc) * 128 + k4;
        *(f32x4*)D = (f32x4){__expf(gacc[0]), __expf(gacc[1]), __expf(gacc[2]), __expf(gacc[3])}; }
    __syncthreads();
}

#endif
#endif
__device__ __forceinline__ void hg_scan(const Args& a, int layer) {
    const int G = gridDim.x;
    int tid_ = threadIdx.x; asm volatile("" : "+v"(tid_));
    for (int e = blockIdx.x * NTHREADS + tid_; e < NB * HGH * HK * HV; e += G * NTHREADS) {
        const int bh = e >> 14, kv = e & 16383, k = kv & 127, v = kv >> 7;
        const float* L = (const float*)(a.ws + WS_L) + (size_t)bh * NSC * 16384 + kv; const float* D = (const float*)(a.ws + WS_D) + bh * NSC * 128 + k;
        float l[NSC], d[NSC];
#pragma unroll
        for (int s = 0; s < NSC; ++s) { l[s] = __builtin_nontemporal_load(L + (size_t)s * 16384); d[s] = D[s * 128]; }
        float S = 0.f;
        bf16* Sst = (bf16*)(a.ws + WS_S) + (size_t)bh * NSC * 16384 + kv;
#pragma unroll
        for (int s = 0; s < NSC; ++s) { Sst[(size_t)s * 16384] = (bf16)pk2(S, S); S = d[s] * S + l[s]; }
        const int b = bh >> 2, h = bh & 3;
        a.out[O_HP + (size_t)((b * DEPTH + layer) * HGH + h) * 16384 + k * 128 + v] = S;
    }
}

__device__ __forceinline__ void hg_sample(const Args& a, int layer, int unit, LAS unsigned char* lds) {
    int tid_ = threadIdx.x; asm volatile("" : "+v"(tid_)); const int tid = tid_, lane = tid & 63, wave = tid >> 6;
    const int seq = unit >> 2, h = unit & 3;
    const int v4 = (tid & 31) * 4, kg = tid >> 5;
    const bf16* prow = (const bf16*)(a.ws + WS_P) + (size_t)(MP + seq) * PW + h * 128;
    const float* lbp = (const float*)(a.ws + WS_LB) + layer * 512 + h * 128 + kg * 8;
    const u32x4 zz = *(const u32x4*)(prow + C_FH + kg * 8), qq = *(const u32x4*)(prow + C_QH + kg * 8);
    const u32x2 vv = *(const u32x2*)(prow + C_IH + v4);
    const float z[8] = {bflo(zz.x), bfhi(zz.x), bflo(zz.y), bfhi(zz.y), bflo(zz.z), bfhi(zz.z), bflo(zz.w), bfhi(zz.w)};
    const float q[8] = {bflo(qq.x), bfhi(qq.x), bflo(qq.y), bfhi(qq.y), bflo(qq.z), bfhi(qq.z), bflo(qq.w), bfhi(qq.w)};
    const f32x4 v = {bflo(vv.x), bfhi(vv.x), bflo(vv.y), bfhi(vv.y)};
    const size_t sidx = (size_t)((seq * DEPTH + layer) * HGH + h) * 16384;
    const float* S0 = a.in[6] + sidx; float* S1 = a.out + O_HS + sidx;
    f32x4 o = {0.f, 0.f, 0.f, 0.f};
#pragma unroll
    for (int i = 0; i < 8; ++i) {
        const float lbv = lbp[i];
        const float sig = 1.f / (1.f + __expf(-z[i])), sigm = 1.f / (1.f + __expf(z[i]));
        const float f = fmaxf(lbv + (1.f - lbv) * sig, 1e-30f), kk = (1.f - lbv) * sigm, qs = silu_f(q[i]);
        const int k = kg * 8 + i;
        const f32x4 s0 = __builtin_nontemporal_load((const f32x4*)(S0 + k * 128 + v4));
        const f32x4 s1 = s0 * f + v * kk;
        __builtin_nontemporal_store(s1, (f32x4*)(S1 + k * 128 + v4));
        o += s1 * qs;
    }
    LAS float* red = (LAS float*)lds;
    LAS float* red2 = (LAS float*)(lds + 8192);
    *(LAS f32x4*)(red + kg * 128 + v4) = o;
    __syncthreads();
    float ov = 0.f;
    if (tid < 128) {
#pragma unroll
        for (int g = 0; g < 16; ++g) ov += red[g * 128 + tid];
        const float ssq = wave_sum(ov * ov);
        if (lane == 0) red2[wave] = ssq;
    }
    __syncthreads();
    if (tid < 128) {
        const float rs = rsqrtf((red2[0] + red2[1]) * (1.f / HV) + EPS);
        const float gh = bf2f(prow[C_GH + tid]);
        bf16* MIX = (bf16*)(a.ws + WS_MIX);
        MIX[(size_t)(MP + seq) * DM + 512 + h * 128 + tid] = (bf16)f2bf(ov * rs * a.in[14][layer * HV + tid] * silu_f(gh));
    }
    __syncthreads();
}


__device__ __forceinline__ void hg_sample2(const Args& a, int layer, int u0, int u1, LAS unsigned char* lds) {
    int tid_ = threadIdx.x; asm volatile("" : "+v"(tid_)); const int tid = tid_, lane = tid & 63, wave = tid >> 6;
    const int v4 = (tid & 31) * 4, kg = tid >> 5;
    const int uu[2] = {u0, u1};
    u32x4 zz[2], qq[2]; u32x2 vv[2]; f32x4 s0[2][8]; float lbv[8];
    const bf16* prow[2]; const float* S0p[2]; float* S1p[2];
#pragma unroll
    for (int t = 0; t < 2; ++t) {
        const int seq = uu[t] >> 2, h = uu[t] & 3;
        prow[t] = (const bf16*)(a.ws + WS_P) + (size_t)(MP + seq) * PW + h * 128;
        zz[t] = *(const u32x4*)(prow[t] + C_FH + kg * 8); qq[t] = *(const u32x4*)(prow[t] + C_QH + kg * 8); vv[t] = *(const u32x2*)(prow[t] + C_IH + v4);
        const size_t sidx = (size_t)((seq * DEPTH + layer) * HGH + h) * 16384;
        S0p[t] = a.in[6] + sidx; S1p[t] = a.out + O_HS + sidx;
#pragma unroll
        for (int i = 0; i < 8; ++i) s0[t][i] = __builtin_nontemporal_load((const f32x4*)(S0p[t] + (kg * 8 + i) * 128 + v4));
    }
    LAS float* red = (LAS float*)lds;
    LAS float* red2 = (LAS float*)(lds + 16384);
#pragma unroll
    for (int t = 0; t < 2; ++t) {
        const int h = uu[t] & 3;
        const float* lbp = (const float*)(a.ws + WS_LB) + layer * 512 + h * 128 + kg * 8;
        const float z[8] = {bflo(zz[t].x), bfhi(zz[t].x), bflo(zz[t].y), bfhi(zz[t].y), bflo(zz[t].z), bfhi(zz[t].z), bflo(zz[t].w), bfhi(zz[t].w)};
        const float q[8] = {bflo(qq[t].x), bfhi(qq[t].x), bflo(qq[t].y), bfhi(qq[t].y), bflo(qq[t].z), bfhi(qq[t].z), bflo(qq[t].w), bfhi(qq[t].w)};
        const f32x4 v = {bflo(vv[t].x), bfhi(vv[t].x), bflo(vv[t].y), bfhi(vv[t].y)};
        f32x4 o = {0.f, 0.f, 0.f, 0.f};
#pragma unroll
        for (int i = 0; i < 8; ++i) {
            const float lb1 = lbp[i];
            const float sig = 1.f / (1.f + __expf(-z[i])), sigm = 1.f / (1.f + __expf(z[i]));
            const float f = fmaxf(lb1 + (1.f - lb1) * sig, 1e-30f), kk = (1.f - lb1) * sigm, qs = silu_f(q[i]);
            const f32x4 s1 = s0[t][i] * f + v * kk;
            __builtin_nontemporal_store(s1, (f32x4*)(S1p[t] + (kg * 8 + i) * 128 + v4));
            o += s1 * qs;
        }
        *(LAS f32x4*)(red + t * 2048 + kg * 128 + v4) = o;
    }
    __syncthreads();
    float ov = 0.f; const int t2 = tid >> 7, vi = tid & 127;
    if (tid < 256) {
#pragma unroll
        for (int g = 0; g < 16; ++g) ov += red[t2 * 2048 + g * 128 + vi];
        const float ssq = wave_sum(ov * ov);
        if (lane == 0) red2[wave] = ssq;
    }
    __syncthreads();
    if (tid < 256) {
        const int seq = uu[t2] >> 2, h = uu[t2] & 3;
        const float rs = rsqrtf((red2[2 * t2] + red2[2 * t2 + 1]) * (1.f / HV) + EPS);
        const float gh = bf2f(prow[t2][C_GH + vi]);
        bf16* MIX = (bf16*)(a.ws + WS_MIX);
        MIX[(size_t)(MP + seq) * DM + 512 + h * 128 + vi] = (bf16)f2bf(ov * rs * a.in[14][layer * HV + vi] * silu_f(gh));
    }
    __syncthreads();
}
#ifdef OL_LDS
struct P2Tile { s16x8 bq[4]; u32x2 ggv[8]; };
#else
struct P2Tile { s16x8 bq[4]; u32x2 olv[8], ggv[8]; };
#endif
__device__ __forceinline__ void p2_load(P2Tile& T, const bf16* P, const bf16* QH, const bf16* OL, size_t row, int h, int quad, LAS unsigned char* qlds = nullptr, int lrow = 0) {
    const bf16* prow = P + row * PW + h * 128;
#ifdef QH_LDS
    if (qlds) {
#pragma unroll
        for (int kq = 0; kq < 4; ++kq) T.bq[kq] = *(const LAS s16x8*)(qlds + lrow * QLDS_ROW + (quad * 8 + 32 * kq) * 2);
    } else
#endif
#pragma unroll
    for (int kq = 0; kq < 4; ++kq) T.bq[kq] = __builtin_nontemporal_load((const s16x8*)(QH + row * 512 + h * 128 + quad * 8 + 32 * kq));
#pragma unroll
    for (int vt = 0; vt < 8; ++vt) {
#ifndef OL_LDS
        T.olv[vt] = __builtin_nontemporal_load((const u32x2*)(OL + row * 512 + h * 128 + 16 * vt + quad * 4));
#endif
        T.ggv[vt] = *(const u32x2*)(prow + C_GH + 16 * vt + quad * 4); }
}
__device__ __forceinline__ void p2_compute(const P2Tile& T, const Args& a, int layer, bf16* MIX, LAS unsigned char* lds, size_t row, int lrow, int h, int l15, int quad) {
    f32x4 o[8]; float ssq = 0.f;
#pragma unroll
    for (int vt = 0; vt < 8; ++vt) {
        f32x4 acc = {0.f, 0.f, 0.f, 0.f};
#pragma unroll
        for (int kq = 0; kq < 4; ++kq) { const s16x8 sa = *(const LAS s16x8*)(lds + ((16 * vt + l15) * 136 + quad * 8 + 32 * kq) * 2); acc = MFMA32(sa, T.bq[kq], acc); }
#ifdef OL_LDS
        const u32x2 ol = *(const LAS u32x2*)(lds + OLDS_OFF + lrow * OLDS_ROW + (16 * vt + quad * 4) * 2);
#else
        const u32x2 ol = T.olv[vt];
#endif
        acc += (f32x4){bflo(ol.x), bfhi(ol.x), bflo(ol.y), bfhi(ol.y)};
        o[vt] = acc; ssq += acc[0] * acc[0] + acc[1] * acc[1] + acc[2] * acc[2] + acc[3] * acc[3];
#if defined(P2_SB8)
#elif defined(P2_SB4)
        if ((vt & 3) == 3) __builtin_amdgcn_sched_barrier(0);
#elif defined(P2_SB2)
        if (vt & 1) __builtin_amdgcn_sched_barrier(0);
#else
        __builtin_amdgcn_sched_barrier(0);
#endif
    }
    ssq += __shfl_xor(ssq, 16); ssq += __shfl_xor(ssq, 32);
    const float rs = rsqrtf(ssq * (1.f / HV) + EPS);
#pragma unroll
    for (int vt = 0; vt < 8; ++vt) {
        const u32x2 gg = T.ggv[vt];
        const f32x4 w = *(const f32x4*)(a.in[14] + layer * HV + 16 * vt + quad * 4);
        const float r0 = o[vt][0] * rs * w[0] * silu_f(bflo(gg.x)), r1 = o[vt][1] * rs * w[1] * silu_f(bfhi(gg.x)), r2 = o[vt][2] * rs * w[2] * silu_f(bflo(gg.y)), r3 = o[vt][3] * rs * w[3] * silu_f(bfhi(gg.y));
        *(u32x2*)(MIX + row * DM + 512 + h * 128 + 16 * vt + quad * 4) = (u32x2){pk2(r0, r1), pk2(r2, r3)};
    }
}
__device__ __forceinline__ void hg_pass2(const Args& a, int layer, int unit, LAS unsigned char* lds) {
    int tid_ = threadIdx.x; asm volatile("" : "+v"(tid_)); const int tid = tid_, lane = tid & 63, wave = tid >> 6, l15 = lane & 15, quad = lane >> 4;
    const int b = unit / (HGH * NSC), h = (unit / NSC) % HGH, sc = unit % NSC;
    const int nsub = (sc == NSC - 1) ? 17 : 16;
    const size_t row0 = (size_t)b * LP + (size_t)sc * 256;
    const bf16* P = (const bf16*)(a.ws + WS_P); bf16* MIX = (bf16*)(a.ws + WS_MIX);
    const bf16* Sst = (const bf16*)(a.ws + WS_S) + (size_t)((b * HGH + h) * NSC + sc) * 16384;
    const bf16* QH = (const bf16*)(a.ws + WS_QH); const bf16* OL = (const bf16*)(a.ws + WS_OL);
    u32x4 sv[4];
#pragma unroll
    for (int j = 0; j < 4; ++j) { const int idx = tid + NTHREADS * j, v = idx >> 4, k8 = (idx & 15) * 8; sv[j] = __builtin_nontemporal_load((const u32x4*)(Sst + v * 128 + k8)); }
    const size_t rowA = row0 + 16 * wave + l15, rowB = rowA + 128;
    P2Tile TA, TB;
#ifdef QH_LDS
    p2_load(TA, P, QH, OL, rowA, h, quad, lds + QLDS_OFF, 16 * wave + l15);
#else
    p2_load(TA, P, QH, OL, rowA, h, quad);
#endif
    p2_load(TB, P, QH, OL, rowB, h, quad);
#pragma unroll
    for (int j = 0; j < 4; ++j) { const int idx = tid + NTHREADS * j, v = idx >> 4, k8 = (idx & 15) * 8;
        *(LAS u32x4*)(lds + (v * 136 + k8) * 2) = sv[j]; }
    __syncthreads();
    p2_compute(TA, a, layer, MIX, lds, rowA, 16 * wave + l15, h, l15, quad);
    p2_compute(TB, a, layer, MIX, lds, rowB, 16 * wave + l15 + 128, h, l15, quad);
    if (wave + 16 < nsub) {
        const size_t rowC = rowA + 256;
        p2_load(TA, P, QH, OL, rowC, h, quad);
        p2_compute(TA, a, layer, MIX, lds, rowC, 16 * wave + l15 + 256, h, l15, quad);
    }
    __syncthreads();
}

constexpr int PA_KROW = 72, PA_V = 272 * PA_KROW * 2, PA_VROW = 280;
#ifdef PATTN_TR
constexpr int PA_VR = 160;
#endif
__device__ __forceinline__ void pattn(const Args& a, int layer, int unit, LAS unsigned char* lds) {
    int tid_ = threadIdx.x; asm volatile("" : "+v"(tid_)); const int tid = tid_, lane = tid & 63, wave = tid >> 6, l15 = lane & 15, quad = lane >> 4;
    int b, nb; const int kvh = unit & 1;
    if (unit < 256) { b = unit >> 7; nb = (unit >> 1) & 63; } else { b = (unit - 256) >> 1; nb = 64; }
    const bf16* P = (const bf16*)(a.ws + WS_P); bf16* MIX = (bf16*)(a.ws + WS_MIX);
    const float* knw = a.in[11] + layer * HD; const float* qnw = a.in[10] + layer * HD;
    u32x4 kxa[5], vxa[5];
#pragma unroll
    for (int j = 0; j < 5; ++j) {
        const int it = tid + NTHREADS * j, kr = it >> 3, c8 = it & 7;
        const int pos = kr < 16 ? kr : (nb - 1) * 128 + (kr - 16);
        const bool valid = (kr < 272) && pos >= 0 && pos < LP;
        const size_t row = (size_t)b * LP + pos;
        kxa[j] = (u32x4){0u, 0u, 0u, 0u}; vxa[j] = (u32x4){0u, 0u, 0u, 0u};
        if (valid) { kxa[j] = *(const u32x4*)(P + row * PW + C_KA + kvh * 64 + c8 * 8); vxa[j] = *(const u32x4*)(P + row * PW + C_VA + kvh * 64 + c8 * 8); }
    }
    u32x4 qn0 = {0u, 0u, 0u, 0u}, qn1 = {0u, 0u, 0u, 0u};
    { const int qt = wave * 4, g = qt >> 3, r0 = (qt & 7) * 16, p = nb * 128 + r0 + l15;
      if (p < LP) { const bf16* qp = P + ((size_t)b * LP + p) * PW + C_QA + (kvh * 4 + g) * 64 + quad * 8; qn0 = *(const u32x4*)qp; qn1 = *(const u32x4*)(qp + 32); } }
#pragma unroll
    for (int j = 0; j < 5; ++j) {
        const int it = tid + NTHREADS * j, kr = it >> 3, c8 = it & 7;
        const int pos = kr < 16 ? kr : (nb - 1) * 128 + (kr - 16);
        const bool valid = (kr < 272) && pos >= 0 && pos < LP;
        const u32x4 kx = kxa[j], vx = vxa[j];
        float kf[8] = {bflo(kx.x), bfhi(kx.x), bflo(kx.y), bfhi(kx.y), bflo(kx.z), bfhi(kx.z), bflo(kx.w), bfhi(kx.w)};
        float ssq = 0.f;
#pragma unroll
        for (int e = 0; e < 8; ++e) ssq += kf[e] * kf[e];
        ssq += __shfl_xor(ssq, 1); ssq += __shfl_xor(ssq, 2); ssq += __shfl_xor(ssq, 4);
        const float rs = rsqrtf(ssq * (1.f / HD) + EPS);
        const f32x4 w0 = *(const f32x4*)(knw + c8 * 8), w1 = *(const f32x4*)(knw + c8 * 8 + 4);
        kf[0] *= rs * w0[0]; kf[1] *= rs * w0[1]; kf[2] *= rs * w0[2]; kf[3] *= rs * w0[3]; kf[4] *= rs * w1[0]; kf[5] *= rs * w1[1]; kf[6] *= rs * w1[2]; kf[7] *= rs * w1[3];
        if (kr < 272) {
            *(LAS u32x4*)(lds + (kr * PA_KROW + c8 * 8) * 2) = (u32x4){pk2(kf[0], kf[1]), pk2(kf[2], kf[3]), pk2(kf[4], kf[5]), pk2(kf[6], kf[7])};
#ifdef PATTN_TR
            *(LAS u32x4*)(lds + PA_V + kr * PA_VR + c8 * 16) = vx;
#else
            const unsigned vr[4] = {vx.x, vx.y, vx.z, vx.w};
#pragma unroll
            for (int e = 0; e < 8; ++e) *(LAS unsigned short*)(lds + PA_V + ((c8 * 8 + e) * PA_VROW + kr) * 2) = (unsigned short)((e & 1) ? (vr[e >> 1] >> 16) : (vr[e >> 1] & 0xffffu));
#endif
        }
        if (valid) {
            float* ok = nullptr; float* ov = nullptr;
            if (nb == 0 && kr < 16) { const size_t o = ((size_t)((b * DEPTH + layer) * NMETA + kr) * NKV + kvh) * HD + c8 * 8; ok = a.out + O_MKP + o; ov = a.out + O_MVP + o; }
            else if (kr >= 144 && pos >= LP - WIN) { const size_t o = ((size_t)((b * DEPTH + layer) * WIN + (pos - (LP - WIN))) * NKV + kvh) * HD + c8 * 8; ok = a.out + O_WKP + o; ov = a.out + O_WVP + o; }
            if (ok) {
                *(f32x4*)ok = (f32x4){kf[0], kf[1], kf[2], kf[3]}; *(f32x4*)(ok + 4) = (f32x4){kf[4], kf[5], kf[6], kf[7]};
                *(f32x4*)ov = (f32x4){bflo(vx.x), bfhi(vx.x), bflo(vx.y), bfhi(vx.y)}; *(f32x4*)(ov + 4) = (f32x4){bflo(vx.z), bfhi(vx.z), bflo(vx.w), bfhi(vx.w)};
            }
        }
    }
    __syncthreads();
    const int nq = (nb == 64) ? 1 : 8;
#ifdef PATTN_U2
#pragma unroll 2
#else
#pragma unroll 1
#endif
    for (int i = 0; i < 4; ++i) {
        const int qt = wave * 4 + i, g = qt >> 3, tb = qt & 7, r0 = tb * 16, head = kvh * 4 + g;
        const int p = nb * 128 + r0 + l15; const bool qvalid = p < LP; const size_t row = (size_t)b * LP + p;
        const u32x4 qx0 = qn0, qx1 = qn1;
        if (i < 3) {
            const int qt2 = qt + 1, g2 = qt2 >> 3, p2 = nb * 128 + (qt2 & 7) * 16 + l15;
            qn0 = (u32x4){0u, 0u, 0u, 0u}; qn1 = (u32x4){0u, 0u, 0u, 0u};
            if (p2 < LP) { const bf16* qp = P + ((size_t)b * LP + p2) * PW + C_QA + (kvh * 4 + g2) * 64 + quad * 8; qn0 = *(const u32x4*)qp; qn1 = *(const u32x4*)(qp + 32); }
        }
        if (tb >= nq) continue;
        u32x2 gg[4];
#pragma unroll
        for (int dt = 0; dt < 4; ++dt) { gg[dt] = (u32x2){0u, 0u}; if (qvalid) gg[dt] = *(const u32x2*)(P + row * PW + C_GA + head * 64 + 16 * dt + quad * 4); }
        const float sink = a.in[12][layer * NQH + head] * 1.4426950408889634f;
        float qf[16] = {bflo(qx0.x), bfhi(qx0.x), bflo(qx0.y), bfhi(qx0.y), bflo(qx0.z), bfhi(qx0.z), bflo(qx0.w), bfhi(qx0.w),
                        bflo(qx1.x), bfhi(qx1.x), bflo(qx1.y), bfhi(qx1.y), bflo(qx1.z), bfhi(qx1.z), bflo(qx1.w), bfhi(qx1.w)};
        float ssq = 0.f;
#pragma unroll
        for (int e = 0; e < 16; ++e) ssq += qf[e] * qf[e];
        ssq += __shfl_xor(ssq, 16); ssq += __shfl_xor(ssq, 32);
        const float rs = rsqrtf(ssq * (1.f / HD) + EPS) * (0.125f * 1.4426950408889634f);
        s16x8 bq[2];
#pragma unroll
        for (int kq = 0; kq < 2; ++kq) {
            const f32x4 w0 = *(const f32x4*)(qnw + quad * 8 + 32 * kq), w1 = *(const f32x4*)(qnw + quad * 8 + 32 * kq + 4);
            const u32x4 pk = {pk2(qf[kq * 8 + 0] * rs * w0[0], qf[kq * 8 + 1] * rs * w0[1]), pk2(qf[kq * 8 + 2] * rs * w0[2], qf[kq * 8 + 3] * rs * w0[3]),
                              pk2(qf[kq * 8 + 4] * rs * w1[0], qf[kq * 8 + 5] * rs * w1[1]), pk2(qf[kq * 8 + 6] * rs * w1[2], qf[kq * 8 + 7] * rs * w1[3])};
            bq[kq] = __builtin_bit_cast(s16x8, pk);
        }
        LAS unsigned char* kb0 = lds + (l15 * PA_KROW + quad * 8) * 2;
        LAS unsigned char* kbt = kb0 + tb * (16 * PA_KROW * 2);
        f32x4 at[10];
#pragma unroll
        for (int r = 0; r < 10; ++r) {
            f32x4 acc = {0.f, 0.f, 0.f, 0.f};
            LAS unsigned char* kp = (r == 0) ? kb0 : kbt + r * (16 * PA_KROW * 2);
#pragma unroll
            for (int kq = 0; kq < 2; ++kq) { const s16x8 ka = *(const LAS s16x8*)(kp + kq * 64); acc = MFMA32(ka, bq[kq], acc); }
            at[r] = acc;
#ifndef PATTN_NOSB
            __builtin_amdgcn_sched_barrier(0);
#endif
        }
        const int lo_b = 32 - (nb - 1) * 128 - 16 * tb;
        const int lor = ((l15 + 17 > lo_b) ? l15 + 17 : lo_b) - quad * 4, hir = 144 + l15 - quad * 4, pmr = (p < 15 ? p : 15) - quad * 4;
        float mx = -1e30f;
#pragma unroll
        for (int r = 0; r < 10; ++r) {
            if (r >= 2 && r <= 8 && nb >= 1) {
#pragma unroll
                for (int j = 0; j < 4; ++j) mx = fmaxf(mx, at[r][j]);
            } else {
#pragma unroll
                for (int j = 0; j < 4; ++j) {
                    const int c = 16 * r + j;
                    const bool vis = (r == 0) ? (c <= pmr) : (c >= lor && c <= hir);
                    const float s = vis ? at[r][j] : -1e30f; at[r][j] = s; mx = fmaxf(mx, s);
                }
            }
        }
        mx = fmaxf(mx, __shfl_xor(mx, 16)); mx = fmaxf(mx, __shfl_xor(mx, 32));
        const float m = fmaxf(mx, sink);
        float sum = 0.f;
#pragma unroll
        for (int r = 0; r < 10; ++r) {
#pragma unroll
            for (int j = 0; j < 4; ++j) { const float e = __builtin_amdgcn_exp2f(at[r][j] - m); at[r][j] = e; sum += e; }
        }
        sum += __shfl_xor(sum, 16); sum += __shfl_xor(sum, 32);
        const float inv = 1.f / (sum + __builtin_amdgcn_exp2f(sink - m));
        f32x4 ot[4];
#pragma unroll
        for (int dt = 0; dt < 4; ++dt) ot[dt] = (f32x4){0.f, 0.f, 0.f, 0.f};
#ifdef PATTN_TR
        LAS unsigned char* vb0 = lds + PA_V + (quad * 4 + (l15 >> 2)) * PA_VR + (l15 & 3) * 8;
        LAS unsigned char* vbt = vb0 + tb * (16 * PA_VR);
#else
        LAS unsigned char* vb0 = lds + PA_V + (l15 * PA_VROW + quad * 4) * 2;
        LAS unsigned char* vbt = vb0 + tb * 32;
#endif
#pragma unroll
        for (int r = 0; r < 10; ++r) {
            const u32x2 pp = {pk2(at[r][0], at[r][1]), pk2(at[r][2], at[r][3])};
            const s16x4 pt = __builtin_bit_cast(s16x4, pp);
#ifdef PATTN_TR
            LAS unsigned char* vp = (r == 0) ? vb0 : vbt + r * (16 * PA_VR);
#pragma unroll
            for (int dt = 0; dt < 4; ++dt) { const s16x4 va = __builtin_amdgcn_ds_read_tr16_b64_v4i16((LAS s16x4*)(vp + dt * 32)); ot[dt] = MFMA16(va, pt, ot[dt]); }
#else
            LAS unsigned char* vp = (r == 0) ? vb0 : vbt + r * 32;
#pragma unroll
            for (int dt = 0; dt < 4; ++dt) { const s16x4 va = *(const LAS s16x4*)(vp + dt * (16 * PA_VROW * 2)); ot[dt] = MFMA16(va, pt, ot[dt]); }
#endif
#ifndef PATTN_NOSB
            __builtin_amdgcn_sched_barrier(0);
#endif
        }
        if (qvalid) {
#pragma unroll
            for (int dt = 0; dt < 4; ++dt) {
                const int d = 16 * dt + quad * 4;
                const float r0v = ot[dt][0] * inv * silu_f(bflo(gg[dt].x)), r1v = ot[dt][1] * inv * silu_f(bfhi(gg[dt].x)), r2v = ot[dt][2] * inv * silu_f(bflo(gg[dt].y)), r3v = ot[dt][3] * inv * silu_f(bfhi(gg[dt].y));
                *(u32x2*)(MIX + row * DM + head * 64 + d) = (u32x2){pk2(r0v, r1v), pk2(r2v, r3v)};
            }
        }
    }
    __syncthreads();
}

constexpr int SA_ROW = 136, SA_K = 0, SA_V = 39936, SA_Q = 79872, SA_P = 81920;
__device__ __forceinline__ void sattn(const Args& a, int layer, int seq, LAS unsigned char* lds) {
    int tid_ = threadIdx.x; asm volatile("" : "+v"(tid_)); const int tid = tid_, lane = tid & 63, wave = tid >> 6;
    const size_t cidx = (size_t)(seq * DEPTH + layer) * WIN * 128, midx = (size_t)(seq * DEPTH + layer) * NMETA * 128;
    const float* ck = a.in[2] + cidx; const float* cv = a.in[3] + cidx; const float* mk = a.in[4] + midx; const float* mv = a.in[5] + midx;
    float* ok = a.out + O_WKS + cidx; float* ov = a.out + O_WVS + cidx;
    const size_t row = MP + seq;
    const bf16* prow = (const bf16*)(a.ws + WS_P) + row * PW;
#pragma unroll
    for (int j = 0; j < 8; ++j) {
        const int idx = tid + NTHREADS * j, r = idx >> 5, c4 = (idx & 31) * 4;
        const f32x4 kx = *(const f32x4*)(ck + r * 128 + c4), vx = *(const f32x4*)(cv + r * 128 + c4);
        if (r >= 1) { *(f32x4*)(ok + (r - 1) * 128 + c4) = kx; *(f32x4*)(ov + (r - 1) * 128 + c4) = vx; }
        *(LAS u32x2*)(lds + SA_K + ((16 + r) * SA_ROW + c4) * 2) = (u32x2){pk2(kx[0], kx[1]), pk2(kx[2], kx[3])};
        *(LAS u32x2*)(lds + SA_V + ((16 + r) * SA_ROW + c4) * 2) = (u32x2){pk2(vx[0], vx[1]), pk2(vx[2], vx[3])};
    }
    { const int r = tid >> 5, c4 = (tid & 31) * 4;
      const f32x4 kx = *(const f32x4*)(mk + r * 128 + c4), vx = *(const f32x4*)(mv + r * 128 + c4);
      *(LAS u32x2*)(lds + SA_K + (r * SA_ROW + c4) * 2) = (u32x2){pk2(kx[0], kx[1]), pk2(kx[2], kx[3])};
      *(LAS u32x2*)(lds + SA_V + (r * SA_ROW + c4) * 2) = (u32x2){pk2(vx[0], vx[1]), pk2(vx[2], vx[3])}; }
    if (wave == 0) {
        const int kvh = lane >> 5, d2 = (lane & 31) * 2;
        const unsigned kk2 = *(const unsigned*)(prow + C_KA + kvh * 64 + d2);
        const float k0 = bflo(kk2), k1 = bfhi(kk2);
        float ssq = k0 * k0 + k1 * k1;
#pragma unroll
        for (int o = 1; o < 32; o <<= 1) ssq += __shfl_xor(ssq, o);
        const float rs = rsqrtf(ssq * (1.f / HD) + EPS);
        const float n0 = k0 * rs * a.in[11][layer * HD + d2], n1 = k1 * rs * a.in[11][layer * HD + d2 + 1];
        ok[127 * 128 + kvh * 64 + d2] = n0; ok[127 * 128 + kvh * 64 + d2 + 1] = n1;
        *(LAS unsigned*)(lds + SA_K + (144 * SA_ROW + kvh * 64 + d2) * 2) = pk2(n0, n1);
    } else if (wave == 1) {
        const int kvh = lane >> 5, d2 = (lane & 31) * 2;
        const unsigned vv2 = *(const unsigned*)(prow + C_VA + kvh * 64 + d2);
        ov[127 * 128 + kvh * 64 + d2] = bflo(vv2); ov[127 * 128 + kvh * 64 + d2 + 1] = bfhi(vv2);
        *(LAS unsigned*)(lds + SA_V + (144 * SA_ROW + kvh * 64 + d2) * 2) = vv2;
    }
    LAS float* Qs = (LAS float*)(lds + SA_Q) + wave * 64; LAS float* Ps = (LAS float*)(lds + SA_P) + wave * 160;
    { const float q = bf2f(prow[C_QA + wave * 64 + lane]); const float ssq = wave_sum(q * q);
      Qs[lane] = q * rsqrtf(ssq * (1.f / HD) + EPS) * a.in[10][layer * HD + lane] * 0.125f; }
    __syncthreads();
    const int kvh = wave >> 2; const float sink = a.in[12][layer * NQH + wave];
    float scv[3]; float mx = -1e30f;
#pragma unroll
    for (int r3 = 0; r3 < 3; ++r3) {
        const int j = lane + 64 * r3; float s = -1e30f;
        if (j < 145 && j != 16) {
            float acc = 0.f;
#pragma unroll
            for (int c = 0; c < 8; ++c) { const u32x4 kx = *(const LAS u32x4*)(lds + SA_K + (j * SA_ROW + kvh * 64 + c * 8) * 2);
                const LAS float* qp = Qs + c * 8;
                acc += qp[0] * bflo(kx.x) + qp[1] * bfhi(kx.x) + qp[2] * bflo(kx.y) + qp[3] * bfhi(kx.y) + qp[4] * bflo(kx.z) + qp[5] * bfhi(kx.z) + qp[6] * bflo(kx.w) + qp[7] * bfhi(kx.w); }
            s = acc;
        }
        scv[r3] = s; mx = fmaxf(mx, s);
    }
    mx = wave_max(mx);
    const float m = fmaxf(mx, sink);
    float sum = 0.f;
#pragma unroll
    for (int r3 = 0; r3 < 3; ++r3) { scv[r3] = __expf(scv[r3] - m); sum += scv[r3]; }
    sum = wave_sum(sum);
    const float inv = 1.f / (sum + __expf(sink - m));
#pragma unroll
    for (int r3 = 0; r3 < 3; ++r3) { const int j = lane + 64 * r3; if (j < 160) Ps[j] = scv[r3] * inv; }
    __syncthreads();
    float o = 0.f;
#pragma unroll 5
    for (int j = 0; j < 145; ++j) o += Ps[j] * bf2f(*(const LAS unsigned short*)(lds + SA_V + (j * SA_ROW + kvh * 64 + lane) * 2));
    const float ga = bf2f(prow[C_GA + wave * 64 + lane]);
    ((bf16*)(a.ws + WS_MIX))[row * DM + wave * 64 + lane] = (bf16)f2bf(o * silu_f(ga));
    __syncthreads();
}


constexpr int S2_ROW = 72, S2_K = 0, S2_V = 145 * S2_ROW * 2  , S2_Q = 41984, S2_P = S2_Q + 4 * 64 * 4  , S2_ST = S2_P + 4 * 160 * 4  , S2_O = S2_ST + 64  ;
__device__ __forceinline__ void sattn2(const Args& a, int layer, int unit, LAS unsigned char* lds) {
    int tid_ = threadIdx.x; asm volatile("" : "+v"(tid_)); const int tid = tid_, lane = tid & 63, wave = tid >> 6;
    const int seq = unit >> 1, kvh = unit & 1;
    const size_t cidx = (size_t)(seq * DEPTH + layer) * WIN * 128 + kvh * 64, midx = (size_t)(seq * DEPTH + layer) * NMETA * 128 + kvh * 64;
    const float* ck = a.in[2] + cidx; const float* cv = a.in[3] + cidx; const float* mk = a.in[4] + midx; const float* mv = a.in[5] + midx;
    float* ok = a.out + O_WKS + cidx; float* ov = a.out + O_WVS + cidx;
    const size_t row = MP + seq;
    const bf16* prow = (const bf16*)(a.ws + WS_P) + row * PW;
#pragma unroll
    for (int j = 0; j < 4; ++j) {
        const int idx = tid + NTHREADS * j, r = idx >> 4, c4 = (idx & 15) * 4;
        const f32x4 kx = __builtin_nontemporal_load((const f32x4*)(ck + r * 128 + c4)), vx = __builtin_nontemporal_load((const f32x4*)(cv + r * 128 + c4));
        if (r >= 1) { __builtin_nontemporal_store(kx, (f32x4*)(ok + (r - 1) * 128 + c4)); __builtin_nontemporal_store(vx, (f32x4*)(ov + (r - 1) * 128 + c4)); }
        *(LAS u32x2*)(lds + S2_K + ((16 + r) * S2_ROW + c4) * 2) = (u32x2){pk2(kx[0], kx[1]), pk2(kx[2], kx[3])};
        *(LAS u32x2*)(lds + S2_V + ((16 + r) * S2_ROW + c4) * 2) = (u32x2){pk2(vx[0], vx[1]), pk2(vx[2], vx[3])};
    }
    if (tid < 256) { const int r = tid >> 4, c4 = (tid & 15) * 4;
      const f32x4 kx = *(const f32x4*)(mk + r * 128 + c4), vx = *(const f32x4*)(mv + r * 128 + c4);
      *(LAS u32x2*)(lds + S2_K + (r * S2_ROW + c4) * 2) = (u32x2){pk2(kx[0], kx[1]), pk2(kx[2], kx[3])};
      *(LAS u32x2*)(lds + S2_V + (r * S2_ROW + c4) * 2) = (u32x2){pk2(vx[0], vx[1]), pk2(vx[2], vx[3])}; }
    if (wave == 4) {
        const int d2 = (lane & 31) * 2;
        const unsigned kk2 = *(const unsigned*)(prow + C_KA + kvh * 64 + d2);
        const float k0 = bflo(kk2), k1 = bfhi(kk2);
        float ssq = k0 * k0 + k1 * k1;
#pragma unroll
        for (int o = 1; o < 32; o <<= 1) ssq += __shfl_xor(ssq, o);
        const float rs = rsqrtf(ssq * (1.f / HD) + EPS);
        const float n0 = k0 * rs * a.in[11][layer * HD + d2], n1 = k1 * rs * a.in[11][layer * HD + d2 + 1];
        if (lane < 32) { ok[127 * 128 + d2] = n0; ok[127 * 128 + d2 + 1] = n1; *(LAS unsigned*)(lds + S2_K + (144 * S2_ROW + d2) * 2) = pk2(n0, n1); }
    } else if (wave == 5) {
        if (lane < 32) { const int d2 = lane * 2; const unsigned vv2 = *(const unsigned*)(prow + C_VA + kvh * 64 + d2);
            ov[127 * 128 + d2] = bflo(vv2); ov[127 * 128 + d2 + 1] = bfhi(vv2); *(LAS unsigned*)(lds + S2_V + (144 * S2_ROW + d2) * 2) = vv2; }
    }
    const int g = wave & 3, hf = wave >> 2, head = kvh * 4 + g;
    LAS float* Qs = (LAS float*)(lds + S2_Q) + g * 64; LAS float* Ps = (LAS float*)(lds + S2_P) + g * 160;
    LAS float* St = (LAS float*)(lds + S2_ST);
    LAS float* Op = (LAS float*)(lds + S2_O);
    if (hf == 0) { const float q = bf2f(prow[C_QA + head * 64 + lane]); const float ssq = wave_sum(q * q);
      Qs[lane] = q * rsqrtf(ssq * (1.f / HD) + EPS) * a.in[10][layer * HD + lane] * 0.125f; }
    __syncthreads();
    const float sink = a.in[12][layer * NQH + head];
    float scv[2]; float mx = -1e30f;
#pragma unroll
    for (int r2 = 0; r2 < 2; ++r2) {
        const int j = (hf == 0) ? lane + 128 * r2 : (r2 == 0 ? 64 + lane : 1000);
        float sc = -1e30f;
        if (j < 145 && j != 16) {
            float acc = 0.f;
#pragma unroll
            for (int c = 0; c < 8; ++c) { const u32x4 kx = *(const LAS u32x4*)(lds + S2_K + (j * S2_ROW + c * 8) * 2);
                const LAS float* qp = Qs + c * 8;
                acc += qp[0] * bflo(kx.x) + qp[1] * bfhi(kx.x) + qp[2] * bflo(kx.y) + qp[3] * bfhi(kx.y) + qp[4] * bflo(kx.z) + qp[5] * bfhi(kx.z) + qp[6] * bflo(kx.w) + qp[7] * bfhi(kx.w); }
            sc = acc;
        }
        scv[r2] = sc; mx = fmaxf(mx, sc);
    }
    mx = wave_max(mx);
    float sum = 0.f;
#pragma unroll
    for (int r2 = 0; r2 < 2; ++r2) { scv[r2] = __expf(scv[r2] - mx); sum += scv[r2]; }
    sum = wave_sum(sum);
    if (lane == 0) { St[(g * 2 + hf) * 2] = mx; St[(g * 2 + hf) * 2 + 1] = sum; }
    __syncthreads();
    {
        const float m0 = St[(g * 2 + 0) * 2], s0 = St[(g * 2 + 0) * 2 + 1], m1 = St[(g * 2 + 1) * 2], s1 = St[(g * 2 + 1) * 2 + 1];
        const float M = fmaxf(fmaxf(m0, m1), sink);
        const float inv = 1.f / (s0 * __expf(m0 - M) + s1 * __expf(m1 - M) + __expf(sink - M));
        const float sc = __expf(mx - M) * inv;
#pragma unroll
        for (int r2 = 0; r2 < 2; ++r2) { const int j = (hf == 0) ? lane + 128 * r2 : (r2 == 0 ? 64 + lane : 1000); if (j < 160) Ps[j] = scv[r2] * sc; }
    }
    __syncthreads();
    float o = 0.f;
    { const int j0 = hf ? 73 : 0, j1 = hf ? 145 : 73;
#pragma unroll 4
      for (int j = j0; j < j1; ++j) o += Ps[j] * bf2f(*(const LAS unsigned short*)(lds + S2_V + (j * S2_ROW + lane) * 2)); }
    if (hf == 1) Op[g * 64 + lane] = o;
    __syncthreads();
    if (hf == 0) {
        o += Op[g * 64 + lane];
        const float ga = bf2f(prow[C_GA + head * 64 + lane]);
        ((bf16*)(a.ws + WS_MIX))[row * DM + head * 64 + lane] = (bf16)f2bf(o * silu_f(ga));
    }
    __syncthreads();
}
constexpr int TAIL_ROW0 = 16384, TAIL_RT = (MS - TAIL_ROW0) / 16;
__device__ __forceinline__ void outproj_tail(const Args& a, int layer) {
    int tid_ = threadIdx.x; asm volatile("" : "+v"(tid_)); const int tid = tid_, lane = tid & 63, wave = tid >> 6, l15 = lane & 15, quad = lane >> 4;
    const int G = gridDim.x;
    const bf16* MIX = (const bf16*)(a.ws + WS_MIX); const bf16* W = (const bf16*)(a.ws + WS_WOUT) + (size_t)layer * DM * DM;
    bf16* XB = (bf16*)(a.ws + WS_XB); unsigned long long* ssn = (unsigned long long*)(a.ws + WS_SS) + (layer + 1 < DEPTH ? layer + 1 : 0) * MPAD;
    const int last = (layer == DEPTH - 1);
    for (int t = blockIdx.x + G * wave; t < TAIL_RT * 64; t += G * 8) {
        const int rt = t >> 6, ct = t & 63;
        const bf16* ap = MIX + (size_t)(TAIL_ROW0 + 16 * rt + l15) * DM + quad * 8;
        const bf16* bp = W + (size_t)(16 * ct + l15) * DM + quad * 8;
        f32x4 acc = {0.f, 0.f, 0.f, 0.f};
#pragma unroll 1
        for (int s0 = 0; s0 < 32; s0 += 8) {
            s16x8 af[8], bf[8];
#pragma unroll
            for (int u = 0; u < 8; ++u) { af[u] = *(const s16x8*)(ap + 32 * (s0 + u)); bf[u] = *(const s16x8*)(bp + 32 * (s0 + u)); }
#pragma unroll
            for (int u = 0; u < 8; ++u) acc = MFMA32(bf[u], af[u], acc);
        }
        const int row = TAIL_ROW0 + 16 * rt + l15, col = 16 * ct + quad * 4;
        const u32x2 xb = *(const u32x2*)(XB + (size_t)row * DM + col);
        const f32x4 v = (f32x4){bflo(xb.x), bfhi(xb.x), bflo(xb.y), bfhi(xb.y)} + acc;
        if (last) {
            float* yr = nullptr;
            if (row < MP) { const int b = row / LP, pos = row - b * LP; if (pos >= NMETA) yr = a.out + O_YP + ((size_t)b * SEQ + pos - NMETA) * DM + col; }
            else if (row < MS) yr = a.out + O_YS + (size_t)(row - MP) * DM + col;
            if (yr) *(f32x4*)yr = v;
        } else {
            *(u32x2*)(XB + (size_t)row * DM + col) = (u32x2){pk2(v[0], v[1]), pk2(v[2], v[3])};
            float part = v[0] * v[0] + v[1] * v[1] + v[2] * v[2] + v[3] * v[3];
            part += __shfl_xor(part, 16); part += __shfl_xor(part, 32);
            if (quad == 0) atomicAdd(ssn + row, (unsigned long long)(part * SS_SCALE));
        }
    }
}

#define XB_TMO      128
#define XB_XCNT(j)  (256  + 64 * (j))
#define XB_XSUB(j)  (1280 + 64 * (j))
#define XB_XGEN(j)  (2304 + 64 * (j))
#define XB_TOP      3328
#define XB_TOPGEN   3392
#define XCD_BAR_WORDS 3456
#define XB_SPIN_CAP (1u << 18)

__device__ __forceinline__ unsigned xb_ld(unsigned* p)              { return __hip_atomic_load(p, __ATOMIC_RELAXED, __HIP_MEMORY_SCOPE_AGENT); }
__device__ __forceinline__ unsigned xb_add(unsigned* p, unsigned v) { return __hip_atomic_fetch_add(p, v, __ATOMIC_RELAXED, __HIP_MEMORY_SCOPE_AGENT); }
__device__ __forceinline__ unsigned xb_xcc_id() { return (unsigned)__builtin_amdgcn_s_getreg((3 << 11) | 20) & 0xFu; }
#define XB_SPIN(cond, bar) do { unsigned _sp = 0; while (cond) { __builtin_amdgcn_s_sleep(1); \
    if ((++_sp & 255u) == 0u) { if (xb_ld(&(bar)[XB_TMO])) break; if (_sp > XB_SPIN_CAP) { atomicAdd(&(bar)[XB_TMO], 1u); break; } } } } while (0)

struct XcdBarrier {
    unsigned* bar; unsigned x;
    volatile LAS unsigned* st;
};

__device__ __forceinline__ XcdBarrier xcd_barrier_post(unsigned* bar, volatile LAS unsigned* st) {
    XcdBarrier b; b.bar = bar; b.x = xb_xcc_id(); b.st = st;
    if (threadIdx.x == 0) (void)xb_add(&bar[XB_XCNT(b.x)], 1u);
    return b;
}
__device__ __forceinline__ void xcd_barrier_complete(unsigned* bar, unsigned x, unsigned& nloc, unsigned& nx) {
    const unsigned G = gridDim.x * gridDim.y * gridDim.z;
    unsigned sum, cnt, mine, sp = 0u;
    for (;;) {
        sum = 0u; cnt = 0u; mine = 0u;
#pragma unroll
        for (unsigned j = 0; j < 16; ++j) { const unsigned c = xb_ld(&bar[XB_XCNT(j)]); sum += c; cnt += (c > 0u) ? 1u : 0u; mine = (j == x) ? c : mine; }
        if (sum == G) break;
        __builtin_amdgcn_s_sleep(1);
        if ((++sp & 255u) == 0u) { if (xb_ld(&bar[XB_TMO])) break; if (sp > XB_SPIN_CAP) { atomicAdd(&bar[XB_TMO], 1u); break; } }
    }
    nloc = mine > 0u ? mine : 1u; nx = cnt > 0u ? cnt : 1u;
}

__device__ __forceinline__ void xcd_barrier(const XcdBarrier& b) {
    asm volatile("s_waitcnt vmcnt(0)" ::: "memory");
    __syncthreads();
    if (threadIdx.x == 0) {
        unsigned* bar = b.bar;
        __builtin_amdgcn_s_waitcnt(0);
        unsigned nloc = b.st[0], nx = b.st[1];
        if (nloc == 0u) { xcd_barrier_complete(bar, b.x, nloc, nx); b.st[0] = nloc; b.st[1] = nx; }
        const unsigned old = xb_add(&bar[XB_XSUB(b.x)], 1u);
        const unsigned gen = old / nloc;
        if (old + 1u == (gen + 1u) * nloc) {
            __builtin_amdgcn_fence(__ATOMIC_RELEASE, "agent");
            asm volatile("s_waitcnt vmcnt(0)" ::: "memory");
            const unsigned og = xb_add(&bar[XB_TOP], 1u);
            const unsigned tg = og / nx;
            if (og + 1u == (tg + 1u) * nx) xb_add(&bar[XB_TOPGEN], 1u);
            else XB_SPIN(xb_ld(&bar[XB_TOPGEN]) == tg, bar);
            __builtin_amdgcn_fence(__ATOMIC_ACQUIRE, "agent");
            xb_add(&bar[XB_XGEN(b.x)], 1u);
            asm volatile("s_waitcnt vmcnt(0)" ::: "memory");
        } else {
            XB_SPIN(xb_ld(&bar[XB_XGEN(b.x)]) == gen, bar);
            __builtin_amdgcn_fence(__ATOMIC_ACQUIRE, "agent");
            asm volatile("s_waitcnt vmcnt(0)" ::: "memory");
        }
    }
    __syncthreads();
}

constexpr int N_PHASES = 1 + 5 * DEPTH;
__global__ void __launch_bounds__(NTHREADS, 2) hymba_fwd(Args a) {
    extern __shared__ __attribute__((aligned(16))) unsigned char lds_raw[];
    LAS unsigned char* lds = (LAS unsigned char*)lds_raw;
    const int G = gridDim.x, bx = blockIdx.x;
    if (threadIdx.x < 64) ((LAS unsigned*)(lds + MISC_OFF))[threadIdx.x] = 0u;
    __syncthreads();
    const XcdBarrier bar = xcd_barrier_post((unsigned*)(a.ws + WS_BAR), (volatile LAS unsigned*)(lds + MISC_OFF));
#ifndef REP_A
#define REP_A 1
#endif
#ifndef REP_P
#define REP_P 1
#endif
#ifndef REP_B
#define REP_B 1
#endif
#ifndef REP_B1
#define REP_B1 1
#endif
#ifndef REP_B2
#define REP_B2 1
#endif
#ifndef REP_B3
#define REP_B3 1
#endif
#ifndef REP_C
#define REP_C 1
#endif
#ifndef REP_D
#define REP_D 1
#endif
    for (int ph = a.ph_lo; ph < a.ph_hi; ++ph) {
#ifndef PHM
#define PHM 0xff
#endif
        if (ph == 0) { for (int rep = 0; rep < REP_P; ++rep) prologue(a, lds); }
        else {
            const int layer = (ph - 1) / 5, st = (ph - 1) % 5;
            if (st == 0) {
#ifdef CONV_FIRST
                { const int nun0 = (MPAD / 256) * (PW / 256), first0 = (G == 256) ? (nun0 - 3 * 256) : 0;
                  convert_layer(a, layer, first0, lds); __syncthreads(); }
#endif
                if (PHM & 2) for (int rep = 0; rep < REP_A; ++rep) {
                pg8::Gemm g{(const pg8::bf16_t*)(a.ws + WS_XB), (const pg8::bf16_t*)(a.ws + WS_WIN) + (size_t)layer * PW * DM, MPAD, PW, DM};
#ifdef SATTN_IN_B
                pg8::StaticOrder S; S.init(MPAD, PW, G, bx);
                EpiP E{(bf16*)(a.ws + WS_P), (const unsigned long long*)(a.ws + WS_SS) + layer * MPAD};
                pg8::gemm_phase<EpiP, pg8::StaticOrder, true, true>(lds, g, S, E); }
#else
                OrderA S; S.so.init(MPAD, PW, G, bx); S.flag = (unsigned*)(a.ws + WS_FLAG) + layer * 64;
                EpiP E{(bf16*)(a.ws + WS_P), (const unsigned long long*)(a.ws + WS_SS) + layer * MPAD};
                pg8::gemm_phase<EpiP, OrderA, true, true>(lds, g, S, E); }
#endif
                { const int nun = (MPAD / 256) * (PW / 256), first = (G == 256) ? (nun - 3 * 256) : 0;
#ifndef CONV_FIRST
                  convert_layer(a, layer, first, lds); __syncthreads();
#endif
#ifndef SATTN_IN_B
                  if (bx >= first) {
                      if (threadIdx.x == 0) { unsigned* fl = (unsigned*)(a.ws + WS_FLAG) + layer * 64; unsigned sp = 0;
                          while (__hip_atomic_load(fl, __ATOMIC_RELAXED, __HIP_MEMORY_SCOPE_AGENT) < SAMPLE_P_WAVES && ++sp < (1u << 22)) __builtin_amdgcn_s_sleep(2);
                          __builtin_amdgcn_fence(__ATOMIC_ACQUIRE, "agent"); asm volatile("s_waitcnt vmcnt(0)" ::: "memory"); }
                      __syncthreads();
                      for (int u = bx - first; u < DB; u += G - first) sattn(a, layer, u, lds);
                  }
#endif
                }
            } else if (st == 1) {
#ifdef STAGGER_XCD
                const bool first = ((bx >> 3) & 1) == 0;
#else
                const bool first = (bx & 1) == 0;
#endif
#ifdef B_SLOT3
                const int slot3 = bx % 3; const bool mid = (slot3 == 1);
#endif
#ifdef VCU_MAP
                const int vb = (G % 8 == 0) ? (bx % 8) * (G / 8) + bx / 8 : bx;
#else
                const int vb = bx;
#endif
#ifndef STREAM_IN_C
#ifdef B_SLOT3
                if (slot3 == 0) { for (int u = bx; u < DB * NKV; u += G) sattn2(a, layer, u, lds);
#else
                if (first) { for (int u = bx; u < DB * NKV; u += G) sattn2(a, layer, u, lds);
#endif
                    if (G == 256) hg_sample2(a, layer, bx, bx + 256, lds); else for (int u = bx; u < DB * HGH; u += G) hg_sample(a, layer, u, lds); }
#endif
#ifdef QH_LDS
                for (int u = vb; u < NB * 65 * NKV; u += G) pattn(a, layer, u, lds);
#ifdef B_SLOT3
                if (mid) { for (int u = bx; u < DB * NKV; u += G) sattn2(a, layer, u, lds); hg_sample2(a, layer, bx, bx + 256, lds); }
#endif
                for (int u = vb; u < NB * HGH * NSC; u += G) hg_pass1(a, layer, u, lds);
#else
                for (int r1 = 0; r1 < REP_B1; ++r1) for (int u = vb; u < NB * HGH * NSC; u += G) hg_pass1(a, layer, u, lds);
                for (int r2 = 0; r2 < REP_B2; ++r2) for (int u = vb; u < NB * 65 * NKV; u += G) pattn(a, layer, u, lds);
#endif
#ifndef STREAM_IN_C
#ifdef B_SLOT3
                if (slot3 == 2) { for (int u = bx; u < DB * NKV; u += G) sattn2(a, layer, u, lds);
#else
                if (!first) { for (int u = bx; u < DB * NKV; u += G) sattn2(a, layer, u, lds);
#endif
                    if (G == 256) hg_sample2(a, layer, bx, bx + 256, lds); else for (int u = bx; u < DB * HGH; u += G) hg_sample(a, layer, u, lds); }
#else
                for (int u = bx; u < DB * NKV; u += G) sattn2(a, layer, u, lds);
#endif
            } else if (st == 2) { for (int rep = 0; rep < REP_C; ++rep) {
                hg_scan(a, layer);
#ifdef STREAM_IN_C
                if (G == 256) hg_sample2(a, layer, bx, bx + 256, lds); else for (int u = bx; u < DB * HGH; u += G) hg_sample(a, layer, u, lds);
#endif
                }
            } else if (st == 3) { for (int rep = 0; rep < REP_D; ++rep)
#ifdef VCU_MAP
                for (int u = (G % 8 == 0) ? (bx % 8) * (G / 8) + bx / 8 : bx; u < NB * HGH * NSC; u += G) hg_pass2(a, layer, u, lds);
#else
                for (int u = bx; u < NB * HGH * NSC; u += G) hg_pass2(a, layer, u, lds);
#endif
            } else if (PHM & 128) {
#ifdef NO_TAIL
                constexpr int EM = MPAD;
#else
                constexpr int EM = TAIL_ROW0;
#ifdef TAIL_STAGGER
                if ((bx & 1) == 0) outproj_tail(a, layer);
#else
                outproj_tail(a, layer);
#endif
#endif
                pg8::Gemm g{(const pg8::bf16_t*)(a.ws + WS_MIX), (const pg8::bf16_t*)(a.ws + WS_WOUT) + (size_t)layer * DM * DM, EM, DM, DM};
                pg8::StaticOrder S; S.init(EM, DM, G, bx);
                const int last = (layer == DEPTH - 1);
                EpiOut E{(bf16*)(a.ws + WS_XB), (unsigned long long*)(a.ws + WS_SS) + (layer + 1 < DEPTH ? layer + 1 : 0) * MPAD, a.out, last};
                pg8::gemm_phase<EpiOut, pg8::StaticOrder, true, true>(lds, g, S, E);
#ifdef TAIL_STAGGER
                if (bx & 1) outproj_tail(a, layer);
#endif
            }
        }
        if (ph + 1 < a.ph_hi) { if (a.ph_hi > 1000) cg::this_grid().sync(); else xcd_barrier(bar); }
    }
}

#ifndef MK_MULTI
#define MK_MULTI 0
#endif
extern "C" void kernel_launch(void* const* d_in, const int* in_sizes, int n_in, void* d_out, int out_size, void* d_ws, size_t ws_size, hipStream_t stream) {
    static int grid = 0;
    if (grid == 0) {
        if (n_in != 16 || (size_t)out_size != O_END || ws_size < WS_END) { fprintf(stderr, "kernel_launch: unexpected shapes (n_in %d out %d ws %zu)\n", n_in, out_size, ws_size); grid = -1; return; }
        int dev = 0, cus = 0, per_cu = 0;
        hipGetDevice(&dev); hipDeviceGetAttribute(&cus, hipDeviceAttributeMultiprocessorCount, dev);
        if (hipFuncSetAttribute((const void*)hymba_fwd, hipFuncAttributeMaxDynamicSharedMemorySize, LDS_BYTES) != hipSuccess) { fprintf(stderr, "kernel_launch: hipFuncSetAttribute failed\n"); grid = -1; return; }
        if (hipOccupancyMaxActiveBlocksPerMultiprocessor(&per_cu, (const void*)hymba_fwd, NTHREADS, LDS_BYTES) != hipSuccess || per_cu < 1) per_cu = 1;
        (void)hipGetLastError();
        grid = cus * 1;
        if (grid <= 0) grid = 256;
#ifdef OL_LDS
        if (grid != 256) { fprintf(stderr, "kernel_launch: built for a 256-CU device (one HGRN2 unit per workgroup); got %d CUs\n", grid); grid = -1; return; }
#endif
    }
    if (grid < 0) return;
    hipMemsetAsync((char*)d_ws + WS_SS, 0, CTL_ZERO_BYTES, stream);
    Args a{};
    for (int i = 0; i < 16; ++i) a.in[i] = (const float*)d_in[i];
    a.out = (float*)d_out; a.ws = (unsigned char*)d_ws;
#if MK_MULTI
    for (int ph = 0; ph < N_PHASES; ++ph) { a.ph_lo = ph; a.ph_hi = ph + 1; hipLaunchKernelGGL(hymba_fwd, dim3(grid), dim3(NTHREADS), LDS_BYTES, stream, a); }
#else
    a.ph_lo = 0; a.ph_hi = N_PHASES;
    void* args[] = {&a};
    hipError_t e = hipLaunchCooperativeKernel((const void*)hymba_fwd, dim3(grid), dim3(NTHREADS), args, LDS_BYTES, stream);
    if (e != hipSuccess) fprintf(stderr, "cooperative launch failed: %s (grid %d)\n", hipGetErrorString(e), grid);
#endif
}
```

```cpp
#include <hip/hip_runtime.h>
#include <hip/hip_cooperative_groups.h>
#include <cstdio>
#include <cstdint>
namespace pg8 {
#define PG8_LAS __attribute__((address_space(3)))
typedef unsigned short bf16_t;
typedef short bf16x8 __attribute__((ext_vector_type(8)));
typedef float f32x4 __attribute__((ext_vector_type(4)));
typedef unsigned u32x4 __attribute__((ext_vector_type(4)));
constexpr int BM = 256, BK = 64, HALF = 128, HTB = HALF * BK * 2  , STAGE_BYTES = 8 * HTB, NXCD = 8, WGM = 8;

__host__ __device__ __forceinline__ int lds_byte(int r, int c) { const int st = (r >> 4) * 2 + (c >> 5), rr = r & 15, cc = c & 31, ob = rr * 64 + cc * 2; return st * 1024 + (ob ^ (((ob >> 9) & 1) << 5)); }
__host__ __device__ __forceinline__ void stage_rc(int b, int& R, int& C) { const int st = b / 1024, sb = b % 1024, swz = sb ^ (((sb >> 9) & 1) << 5); R = (st >> 1) * 16 + swz / 64; C = (st & 1) * 32 + (swz % 64) / 2; }
__host__ __device__ __forceinline__ int perm32(int rho) { const int n = rho >> 4, i = rho & 15; return 8 * (i >> 2) + 4 * n + (i & 3); }

struct Unit { int pm, pn; };
struct Gemm { const bf16_t* A; const bf16_t* Bt; int M, N, K; };

struct StaticOrder {
    int nM, nN, nwg, G, c;
    __host__ __device__ void init(int M, int N, int G_, int c_) { nM = M / BM; nN = N / BM; nwg = nM * nN; G = G_; c = c_; }
    __host__ __device__ bool next(int i, Unit& u) const {
        const long L = (long)i * G + c; if (L >= nwg) return false;
        int wgid = (int)L; { const int q = nwg / NXCD, r = nwg % NXCD, xcd = wgid % NXCD, off = wgid / NXCD; wgid = (xcd < r ? xcd * (q + 1) : r * (q + 1) + (xcd - r) * q) + off; }
        const int nig = WGM * nN, gid = wgid / nig, fm = gid * WGM, gsz = (nM - fm) < WGM ? (nM - fm) : WGM;
        u.pm = fm + ((wgid % nig) % gsz); u.pn = (wgid % nig) / gsz; return true;
    }
    __device__ __forceinline__ void a_ready(const Unit&) const {}
    __device__ __forceinline__ void done(const Unit&) const {}
};
__device__ __forceinline__ unsigned cvt_pk_bf16(float lo, float hi) { unsigned r; asm volatile("v_cvt_pk_bf16_f32 %0, %1, %2" : "=v"(r) : "v"(lo), "v"(hi)); return r; }
template <class Epi, class Sched, bool ALIGN_EPI = false, bool SP2 = false>
__device__ __forceinline__ void gemm_phase(PG8_LAS unsigned char* lds, const Gemm g, const Sched& S, const Epi& E) {
    int tid_ = threadIdx.x; asm volatile("" : "+v"(tid_)); const int tid = tid_, wid = __builtin_amdgcn_readfirstlane(tid >> 6), lane = tid & 63, wr = wid >> 2, wc = wid & 3, fr = lane & 15, fq = lane >> 4;
    const int K = g.K, nt = K / BK;
    unsigned voffA[2], voffB[2];
#pragma unroll
    for (int i = 0; i < 2; ++i) { int R, C; stage_rc(tid * 16 + i * 8192, R, C); const int Rb = Epi::PERM ? ((R & ~31) + perm32(R & 31)) : R;
        voffA[i] = (unsigned)(R * K + C) * 2u; voffB[i] = (unsigned)(Rb * K + C) * 2u; }
    const size_t kstep = (size_t)(BK * 2);
    const size_t hstep = (size_t)HALF * K * 2;
    const size_t tstep = 2 * hstep;
    const unsigned ldsw = (unsigned)wid * 1024u;
    const int aoff = lds_byte(wr * 64 + fr, fq * 8), boff = lds_byte(wc * 32 + fr, fq * 8);
#define PG8_SA(b, h) (((b) * 2 + (h)) * HTB)
#define PG8_SB(b, h) ((4 + (b) * 2 + (h)) * HTB)
#define PG8_STAGE(bufoff, gbase, voff) do { _Pragma("unroll") for (int _i = 0; _i < 2; ++_i) \
        __builtin_amdgcn_global_load_lds((const unsigned*)((const char*)(gbase) + (voff)[_i]), (PG8_LAS unsigned*)(lds + (bufoff) + ldsw + _i * 8192), 16, 0, 0); } while (0)
#define PG8_LDA(dst, b, h) do { _Pragma("unroll") for (int m = 0; m < 4; ++m) _Pragma("unroll") for (int k = 0; k < 2; ++k) dst[m][k] = *(const PG8_LAS bf16x8*)(lds + PG8_SA(b, h) + aoff + m * 2048 + k * 1024); } while (0)
#define PG8_LDB(dst, b, h) do { _Pragma("unroll") for (int n = 0; n < 2; ++n) _Pragma("unroll") for (int k = 0; k < 2; ++k) dst[n][k] = *(const PG8_LAS bf16x8*)(lds + PG8_SB(b, h) + boff + n * 2048 + k * 1024); } while (0)
#define PG8_MMA(ai, bj, At, Bt) do { __builtin_amdgcn_s_setprio(1); _Pragma("unroll") for (int m = 0; m < 4; ++m) _Pragma("unroll") for (int n = 0; n < 2; ++n) _Pragma("unroll") for (int k = 0; k < 2; ++k) \
        acc[ai][bj][m][n] = __builtin_amdgcn_mfma_f32_16x16x32_bf16(Bt[n][k], At[m][k], acc[ai][bj][m][n], 0, 0, 0); __builtin_amdgcn_s_setprio(0); } while (0)
#define PG8_WAIT_V(n) asm volatile("s_waitcnt vmcnt(" #n ")" ::: "memory")
#define PG8_WAIT_L(n) asm volatile("s_waitcnt lgkmcnt(" #n ")" ::: "memory")
#define PG8_BAR __builtin_amdgcn_s_barrier()
#define PG8_SCHED __builtin_amdgcn_sched_barrier(0)
    Unit cur, nxt; int ui = 0;
    if (!S.next(0, cur)) return;
    f32x4 acc[2][2][4][2];
#pragma unroll
    for (int a = 0; a < 2; ++a)
#pragma unroll
        for (int b = 0; b < 2; ++b)
#pragma unroll
            for (int m = 0; m < 4; ++m)
#pragma unroll
                for (int n = 0; n < 2; ++n) acc[a][b][m][n] = (f32x4){0.f, 0.f, 0.f, 0.f};
    bf16x8 At[4][2], B0[2][2], B1[2][2];
    const char* cA = (const char*)g.A + (size_t)cur.pm * tstep; const char* cB = (const char*)g.Bt + (size_t)cur.pn * tstep;
    S.a_ready(cur);
    if constexpr (SP2) {
        PG8_STAGE(PG8_SB(0, 0), cB, voffB); PG8_STAGE(PG8_SB(0, 1), cB + hstep, voffB); PG8_STAGE(PG8_SA(0, 0), cA, voffA); PG8_STAGE(PG8_SA(0, 1), cA + hstep, voffA);
        if (wr == 1) PG8_BAR;
        PG8_WAIT_V(2); PG8_BAR;
        PG8_STAGE(PG8_SB(1, 0), cB + kstep, voffB); PG8_STAGE(PG8_SA(1, 0), cA + kstep, voffA); PG8_STAGE(PG8_SB(1, 1), cB + hstep + kstep, voffB);
        PG8_WAIT_V(6); PG8_BAR;
    } else {
        PG8_STAGE(PG8_SB(0, 0), cB, voffB); PG8_STAGE(PG8_SA(0, 0), cA, voffA); PG8_STAGE(PG8_SB(0, 1), cB + hstep, voffB); PG8_STAGE(PG8_SA(0, 1), cA + hstep, voffA);
        if (wr == 1) PG8_BAR;
        PG8_WAIT_V(4); PG8_BAR;
        PG8_STAGE(PG8_SB(1, 0), cB + kstep, voffB); PG8_STAGE(PG8_SA(1, 0), cA + kstep, voffA); PG8_STAGE(PG8_SB(1, 1), cB + hstep + kstep, voffB);
        PG8_WAIT_V(6); PG8_BAR;
    }
    for (;;) {
        const bool has_next = S.next(ui + 1, nxt);
        const char* nA = has_next ? (const char*)g.A + (size_t)nxt.pm * tstep : cA; const char* nB = has_next ? (const char*)g.Bt + (size_t)nxt.pn * tstep : cB;
        for (int t = 0; t < nt; t += 2) {
            const bool last = (t == nt - 2);
            const char* a1 = cA + (size_t)(t + 1) * kstep;
            const char* a2 = last ? nA : cA + (size_t)(t + 2) * kstep; const char* b2 = last ? nB : cB + (size_t)(t + 2) * kstep;
            const char* a3 = a2 + kstep; const char* b3 = b2 + kstep;
            if (last && has_next) S.a_ready(nxt);
            if constexpr (SP2) {
            PG8_LDB(B0, 0, 0); PG8_LDB(B1, 0, 1); PG8_SCHED; PG8_LDA(At, 0, 0); PG8_STAGE(PG8_SA(1, 1), a1 + hstep, voffA);
            PG8_WAIT_V(8); PG8_WAIT_L(0); PG8_BAR; PG8_MMA(0, 0, At, B0); PG8_MMA(0, 1, At, B1); PG8_BAR; PG8_SCHED;
            PG8_LDA(At, 0, 1); PG8_STAGE(PG8_SB(0, 0), b2, voffB); PG8_STAGE(PG8_SB(0, 1), b2 + hstep, voffB); PG8_STAGE(PG8_SA(0, 0), a2, voffA);
            PG8_WAIT_V(8); PG8_WAIT_L(0); PG8_BAR; PG8_MMA(1, 0, At, B0); PG8_MMA(1, 1, At, B1); PG8_BAR; PG8_SCHED;
            PG8_LDB(B0, 1, 0); PG8_LDB(B1, 1, 1); PG8_SCHED; PG8_LDA(At, 1, 0); PG8_STAGE(PG8_SA(0, 1), a2 + hstep, voffA);
            PG8_WAIT_V(8); PG8_WAIT_L(0); PG8_BAR; PG8_MMA(0, 0, At, B0); PG8_MMA(0, 1, At, B1); PG8_BAR; PG8_SCHED;
            PG8_LDA(At, 1, 1); PG8_STAGE(PG8_SB(1, 0), b3, voffB); PG8_STAGE(PG8_SB(1, 1), b3 + hstep, voffB); PG8_STAGE(PG8_SA(1, 0), a3, voffA);
            PG8_WAIT_V(8); PG8_WAIT_L(0); PG8_BAR; PG8_MMA(1, 0, At, B0); PG8_MMA(1, 1, At, B1); PG8_BAR; PG8_SCHED;
            } else {
            PG8_LDB(B0, 0, 0); PG8_SCHED; PG8_LDA(At, 0, 0); PG8_STAGE(PG8_SA(1, 1), a1 + hstep, voffA);
            PG8_WAIT_L(8); PG8_BAR; PG8_WAIT_L(0); PG8_MMA(0, 0, At, B0); PG8_BAR; PG8_SCHED;
            PG8_LDB(B1, 0, 1); PG8_STAGE(PG8_SB(0, 0), b2, voffB);
            PG8_BAR; PG8_WAIT_L(0); PG8_MMA(0, 1, At, B1); PG8_BAR;
            PG8_LDA(At, 0, 1); PG8_STAGE(PG8_SA(0, 0), a2, voffA);
            PG8_BAR; PG8_WAIT_L(0); PG8_MMA(1, 0, At, B0); PG8_BAR; PG8_SCHED;
            PG8_STAGE(PG8_SB(0, 1), b2 + hstep, voffB);
            PG8_WAIT_V(6); PG8_BAR; PG8_MMA(1, 1, At, B1); PG8_BAR;
            PG8_LDB(B0, 1, 0); PG8_SCHED; PG8_LDA(At, 1, 0); PG8_STAGE(PG8_SA(0, 1), a2 + hstep, voffA);
            PG8_WAIT_L(8); PG8_BAR; PG8_WAIT_L(0); PG8_MMA(0, 0, At, B0); PG8_BAR; PG8_SCHED;
            PG8_LDB(B1, 1, 1); PG8_STAGE(PG8_SB(1, 0), b3, voffB);
            PG8_BAR; PG8_WAIT_L(0); PG8_MMA(0, 1, At, B1); PG8_BAR;
            PG8_LDA(At, 1, 1); PG8_STAGE(PG8_SA(1, 0), a3, voffA);
            PG8_BAR; PG8_WAIT_L(0); PG8_MMA(1, 0, At, B0); PG8_BAR; PG8_SCHED;
            PG8_STAGE(PG8_SB(1, 1), b3 + hstep, voffB);
            PG8_WAIT_V(6); PG8_BAR; PG8_MMA(1, 1, At, B1); PG8_BAR;
            }
        }
        if constexpr (ALIGN_EPI) { if (wr == 0) PG8_BAR; }
        if constexpr (!Epi::AFTER_DRAIN) { E(acc, cur, wr, wc, fr, fq); S.done(cur); }
        if (!has_next) break;
#pragma unroll
        for (int a = 0; a < 2; ++a)
#pragma unroll
            for (int b = 0; b < 2; ++b)
#pragma unroll
                for (int m = 0; m < 4; ++m)
#pragma unroll
                    for (int n = 0; n < 2; ++n) acc[a][b][m][n] = (f32x4){0.f, 0.f, 0.f, 0.f};
        cur = nxt; cA = nA; cB = nB; ++ui;
        if constexpr (ALIGN_EPI) { if (wr == 1) PG8_BAR; }
    }
    PG8_WAIT_V(0);
    if constexpr (!ALIGN_EPI) { if (wr == 0) PG8_BAR; }
    PG8_BAR;
    if constexpr (Epi::AFTER_DRAIN) { E.fused(acc, cur, wr, wc, fr, fq, lds, wid, lane); S.done(cur); }
#undef PG8_SA
#undef PG8_SB
#undef PG8_STAGE
#undef PG8_LDA
#undef PG8_LDB
#undef PG8_MMA
#undef PG8_WAIT_V
#undef PG8_WAIT_L
#undef PG8_BAR
#undef PG8_SCHED
}
}

namespace cg = cooperative_groups;
#define GAS __attribute__((address_space(1)))
#define LAS __attribute__((address_space(3)))
typedef unsigned short bf16;
typedef float f32x4 __attribute__((ext_vector_type(4)));
typedef short s16x8 __attribute__((ext_vector_type(8)));
typedef short s16x4 __attribute__((ext_vector_type(4)));
typedef unsigned u32x4 __attribute__((ext_vector_type(4)));
typedef unsigned u32x2 __attribute__((ext_vector_type(2)));

constexpr int DM = 1024, NB = 2, SEQ = 8192, DEPTH = 4, DB = 128, NMETA = 16, WIN = 128, HD = 64, NQH = 8, NKV = 2;
constexpr int HGH = 4, HK = 128, HV = 128, PW = 3328;
constexpr int LP = SEQ + NMETA;
constexpr int MP = NB * LP;
constexpr int MS = MP + DB;
constexpr int MPAD = 16640;
constexpr int C_QA = 0, C_KA = 512, C_VA = 640, C_GA = 768, C_QH = 1280, C_FH = 1792, C_IH = 2304, C_GH = 2816;
constexpr int NSC = 32;
constexpr float EPS = 1e-6f;
constexpr int NTHREADS = 512;
constexpr int LDS_BYTES = 163840;
constexpr int OLDS_OFF = 47104, OLDS_ROW = 264;
constexpr int QLDS_OFF = 118912, QLDS_ROW = 272;

constexpr size_t MiB = 1u << 20;
constexpr size_t WS_SS = 0, CTL_ZERO_BYTES = 1 * MiB;
constexpr float SS_SCALE = 16777216.f;
constexpr size_t WS_LB = 1 * MiB;
constexpr size_t WS_WIN = 2 * MiB;
constexpr size_t WS_WOUT = 28 * MiB;
constexpr size_t WS_XB = 36 * MiB;
constexpr size_t WS_X = 69 * MiB;
constexpr size_t WS_P = 134 * MiB;
constexpr size_t WS_MIX = 240 * MiB;
constexpr size_t WS_L = 273 * MiB;
constexpr size_t WS_D = 290 * MiB;
constexpr size_t WS_FLAG = 900 * 1024;
constexpr size_t WS_BAR = 768 * 1024;
constexpr size_t WS_QH = 291 * MiB;
constexpr size_t WS_OL = 308 * MiB;
constexpr size_t WS_S = 325 * MiB;
constexpr size_t WS_END = 342 * MiB;
constexpr int MISC_OFF = 159744;

constexpr size_t O_YP = 0, O_YS = O_YP + (size_t)NB * SEQ * DM, O_WKP = O_YS + (size_t)DB * DM, O_WVP = O_WKP + 131072, O_MKP = O_WVP + 131072,
                 O_MVP = O_MKP + 16384, O_HP = O_MVP + 16384, O_WKS = O_HP + 524288, O_WVS = O_WKS + 8388608, O_HS = O_WVS + 8388608, O_END = O_HS + 33554432;

struct Args { const float* in[16]; float* out; unsigned char* ws; int ph_lo, ph_hi; };

__device__ __forceinline__ float bflo(unsigned u) { return __builtin_bit_cast(float, u << 16); }
__device__ __forceinline__ float bfhi(unsigned u) { return __builtin_bit_cast(float, u & 0xffff0000u); }
__device__ __forceinline__ float bf2f(unsigned short h) { return __builtin_bit_cast(float, (unsigned)h << 16); }
__device__ __forceinline__ unsigned f2bf(float f) { unsigned u = __builtin_bit_cast(unsigned, f); return (u + 0x7fffu + ((u >> 16) & 1u)) >> 16; }
typedef float f32x2_t __attribute__((ext_vector_type(2)));
typedef __bf16 bf16x2_t __attribute__((ext_vector_type(2)));
__device__ __forceinline__ unsigned pk2(float lo, float hi) { f32x2_t v = {lo, hi}; bf16x2_t b = __builtin_convertvector(v, bf16x2_t); return __builtin_bit_cast(unsigned, b); }
__device__ __forceinline__ unsigned pk2s(float lo, float hi) {
    const unsigned a = __builtin_bit_cast(unsigned, lo) + 0x8000u, b = __builtin_bit_cast(unsigned, hi) + 0x8000u;
    return __builtin_amdgcn_perm(b, a, 0x07060302u);
}
__device__ __forceinline__ f32x4 zero_acc() { f32x4 z = {0.f, 0.f, 0.f, 0.f}; asm volatile("" : "+v"(z)); return z; }
__device__ __forceinline__ float silu_f(float x) { return x * __builtin_amdgcn_rcpf(1.f + __expf(-x)); }
__device__ __forceinline__ float wave_sum(float v) {
#pragma unroll
    for (int o = 1; o < 64; o <<= 1) v += __shfl_xor(v, o);
    return v;
}
__device__ __forceinline__ float wave_max(float v) {
#pragma unroll
    for (int o = 1; o < 64; o <<= 1) v = fmaxf(v, __shfl_xor(v, o));
    return v;
}
#define MFMA32(a, b, c) __builtin_amdgcn_mfma_f32_16x16x32_bf16((a), (b), (c), 0, 0, 0)
#define MFMA_DRAIN() do { __builtin_amdgcn_sched_barrier(0); asm volatile("s_nop 15\n\ts_nop 15"); __builtin_amdgcn_sched_barrier(0); } while (0)
#define CVT_GAP() do { __builtin_amdgcn_sched_barrier(0); asm volatile("s_nop 3"); __builtin_amdgcn_sched_barrier(0); } while (0)
#define MFMA16(a, b, c) __builtin_amdgcn_mfma_f32_16x16x16bf16_1k((a), (b), (c), 0, 0, 0)
#define LDS_WAIT() asm volatile("s_waitcnt lgkmcnt(0)" ::: "memory")

struct EpiP {
    static constexpr bool PERM = true, AFTER_DRAIN = false;
    bf16* P; const unsigned long long* ss;
    __device__ __forceinline__ void operator()(const pg8::f32x4 (&acc)[2][2][4][2], const pg8::Unit& u, int wr, int wc, int fr, int fq) const {
        const int row0 = u.pm * 256 + wr * 64 + fr, col0 = u.pn * 256 + wc * 32 + 8 * fq;
        unsigned long long sv[8];
#pragma unroll
        for (int g = 0; g < 8; ++g) sv[g] = ss[row0 + (g >> 2) * 128 + (g & 3) * 16];
#pragma unroll
        for (int ai = 0; ai < 2; ++ai)
#pragma unroll
            for (int m = 0; m < 4; ++m) {
                const int row = row0 + ai * 128 + m * 16;
                const float rs = rsqrtf((float)sv[ai * 4 + m] * (1.f / (SS_SCALE * DM)) + EPS);
                bf16* rowp = P + (size_t)row * PW + col0;
#pragma unroll
                for (int bj = 0; bj < 2; ++bj) {
                    const pg8::f32x4 v0 = acc[ai][bj][m][0] * rs, v1 = acc[ai][bj][m][1] * rs;
                    u32x4 w; w.x = pk2(v0[0], v0[1]); w.y = pk2(v0[2], v0[3]); w.z = pk2(v1[0], v1[1]); w.w = pk2(v1[2], v1[3]);
                    *(u32x4*)(rowp + bj * 128) = w;
                }
            }
    }
};
struct EpiOut {
    static constexpr bool PERM = true, AFTER_DRAIN = false;
    bf16* XB; unsigned long long* ssn; float* out; int last;
    __device__ __forceinline__ void operator()(const pg8::f32x4 (&acc)[2][2][4][2], const pg8::Unit& u, int wr, int wc, int fr, int fq) const {
        const int row0 = u.pm * 256 + wr * 64 + fr, col0 = u.pn * 256 + wc * 32 + 8 * fq;
#pragma unroll
        for (int ai = 0; ai < 2; ++ai) {
            u32x4 xv[1][4][2];
#pragma unroll
            for (int m = 0; m < 4; ++m) { const bf16* xr = XB + (size_t)(row0 + ai * 128 + m * 16) * DM + col0;
#pragma unroll
                for (int bj = 0; bj < 2; ++bj) xv[0][m][bj] = *(const u32x4*)(xr + bj * 128); }
#pragma unroll
            for (int m = 0; m < 4; ++m) {
                const int row = row0 + ai * 128 + m * 16;
                float part = 0.f;
                float* yr = nullptr;
                if (last) {
                    if (row < MP) { const int b = row / LP, pos = row - b * LP; if (pos >= NMETA) yr = out + O_YP + ((size_t)b * SEQ + pos - NMETA) * DM + col0; }
                    else if (row < MS) yr = out + O_YS + (size_t)(row - MP) * DM + col0;
                }
#pragma unroll
                for (int bj = 0; bj < 2; ++bj) {
                    const u32x4 xb = xv[0][m][bj];
                    const pg8::f32x4 x0 = {bflo(xb.x), bfhi(xb.x), bflo(xb.y), bfhi(xb.y)}, x1 = {bflo(xb.z), bfhi(xb.z), bflo(xb.w), bfhi(xb.w)};
                    const pg8::f32x4 v0 = x0 + acc[ai][bj][m][0], v1 = x1 + acc[ai][bj][m][1];
                    if (last) {
                        if (yr) { __builtin_nontemporal_store(v0, (pg8::f32x4*)(yr + bj * 128)); __builtin_nontemporal_store(v1, (pg8::f32x4*)(yr + bj * 128 + 4)); }
                    } else {
                        u32x4 w; w.x = pk2(v0[0], v0[1]); w.y = pk2(v0[2], v0[3]); w.z = pk2(v1[0], v1[1]); w.w = pk2(v1[2], v1[3]);
                        *(u32x4*)(XB + (size_t)row * DM + col0 + bj * 128) = w;
                        part += v0[0] * v0[0] + v0[1] * v0[1] + v0[2] * v0[2] + v0[3] * v0[3] + v1[0] * v1[0] + v1[1] * v1[1] + v1[2] * v1[2] + v1[3] * v1[3];
                    }
                }
                if (!last) {
                    part += __shfl_xor(part, 16); part += __shfl_xor(part, 32);
                    if (fq == 0) atomicAdd(ssn + row, (unsigned long long)(part * SS_SCALE));
                }
            }
        }
    }
};

struct OrderA {
    pg8::StaticOrder so; unsigned* flag;
    __device__ __forceinline__ bool next(int i, pg8::Unit& u) const {
        const long L = (long)i * so.G + so.c; if (L >= so.nwg) return false;
        pg8::StaticOrder t = so; t.c = (int)(so.nwg - 1 - L); t.G = so.nwg;
        return t.next(0, u);
    }
    __device__ __forceinline__ void a_ready(const pg8::Unit&) const {}
    __device__ __forceinline__ void done(const pg8::Unit& u) const {
        if (u.pm == MPAD / 256 - 1) {
            asm volatile("s_waitcnt vmcnt(0)" ::: "memory");
            __builtin_amdgcn_fence(__ATOMIC_RELEASE, "agent");
            asm volatile("s_waitcnt vmcnt(0)" ::: "memory");
            if ((threadIdx.x & 63) == 0) __hip_atomic_fetch_add(flag, 1u, __ATOMIC_RELAXED, __HIP_MEMORY_SCOPE_AGENT);
        }
    }
};
constexpr unsigned SAMPLE_P_WAVES = (PW / 256) * 8;

__device__ __forceinline__ void transpose_item(const float* W, int K, int N, bf16* WT, const float* scale, LAS float* scr, int item, int lane) {
    const int nblk = N / 32, kb = item / nblk, nb = item % nblk, k0 = 64 * kb, n0 = 32 * nb;
    float wv[32];
#pragma unroll
    for (int i = 0; i < 32; ++i) wv[i] = __builtin_nontemporal_load(W + (size_t)(k0 + 2 * i + (lane >> 5)) * N + n0 + (lane & 31));
#pragma unroll
    for (int i = 0; i < 32; ++i) { const int kk = 2 * i + (lane >> 5); const float s = scale ? scale[k0 + kk] : 1.f; scr[kk * 33 + (lane & 31)] = wv[i] * s; }
    LDS_WAIT();
    const int c = lane & 7;
#pragma unroll
    for (int j = 0; j < 4; ++j) { const int n = (lane >> 3) + 8 * j; const LAS float* s = scr + (8 * c) * 33 + n;
        u32x4 o; o.x = pk2(s[0 * 33], s[1 * 33]); o.y = pk2(s[2 * 33], s[3 * 33]); o.z = pk2(s[4 * 33], s[5 * 33]); o.w = pk2(s[6 * 33], s[7 * 33]);
        *(u32x4*)(WT + (size_t)(n0 + n) * K + k0 + 8 * c) = o; }
    LDS_WAIT();
}

__device__ __forceinline__ void prologue(const Args& a, LAS unsigned char* lds) {
    int tid_ = threadIdx.x; asm volatile("" : "+v"(tid_)); const int tid = tid_, lane = tid & 63, wave = tid >> 6, G = gridDim.x;
    const int gw = blockIdx.x * 8 + wave, NGW = G * 8;
    LAS float* scr = (LAS float*)(lds + wave * 8704);
    bf16* Win_t = (bf16*)(a.ws + WS_WIN);
    constexpr int I_IN = (DM / 64) * (PW / 32);
    for (int it = gw; it < I_IN; it += NGW) transpose_item(a.in[9], DM, PW, Win_t, a.in[8], scr, it, lane);
    bf16* XB = (bf16*)(a.ws + WS_XB); unsigned long long* ss0 = (unsigned long long*)(a.ws + WS_SS);
    for (int row0 = gw; row0 < MPAD; row0 += 4 * NGW) {
        f32x4 v[4][4]; float sq[4];
#pragma unroll
        for (int r = 0; r < 4; ++r) {
            const int row = row0 + r * NGW;
            const float* src = nullptr;
            if (row < MP) { const int b = row / LP, pos = row - b * LP; src = pos < NMETA ? a.in[7] + (size_t)pos * DM : a.in[0] + ((size_t)b * SEQ + pos - NMETA) * DM; }
            else if (row < MS) src = a.in[1] + (size_t)(row - MP) * DM;
#pragma unroll
            for (int j = 0; j < 4; ++j) v[r][j] = src ? __builtin_nontemporal_load((const f32x4*)src + lane + 64 * j) : (f32x4){0.f, 0.f, 0.f, 0.f};
        }
#pragma unroll
        for (int r = 0; r < 4; ++r) {
            float t = 0.f;
#pragma unroll
            for (int j = 0; j < 4; ++j) t += v[r][j][0] * v[r][j][0] + v[r][j][1] * v[r][j][1] + v[r][j][2] * v[r][j][2] + v[r][j][3] * v[r][j][3];
            sq[r] = wave_sum(t);
        }
#pragma unroll
        for (int r = 0; r < 4; ++r) {
            const int row = row0 + r * NGW;
            if (row < MPAD) {
#pragma unroll
                for (int j = 0; j < 4; ++j) { u32x2 w; w.x = pk2(v[r][j][0], v[r][j][1]); w.y = pk2(v[r][j][2], v[r][j][3]); *((u32x2*)(XB + (size_t)row * DM) + lane + 64 * j) = w; }
                if (lane == 0) ss0[row] = (unsigned long long)(sq[r] * SS_SCALE);
            }
        }
    }
    if (blockIdx.x == 0) {
        const float* lg = a.in[13]; float* lb = (float*)(a.ws + WS_LB);
        const float l0 = lg[tid], l1 = lg[512 + tid], l2 = lg[1024 + tid], l3 = lg[1536 + tid];
        const float mx = fmaxf(fmaxf(l0, l1), fmaxf(l2, l3));
        const float e0 = __expf(l0 - mx), e1 = __expf(l1 - mx), e2 = __expf(l2 - mx), e3 = __expf(l3 - mx), inv = 1.f / (e0 + e1 + e2 + e3);
        lb[tid] = 0.f; lb[512 + tid] = e1 * inv; lb[1024 + tid] = (e1 + e2) * inv; lb[1536 + tid] = (e1 + e2 + e3) * inv;
    }
    __syncthreads();
}

__device__ __forceinline__ void convert_layer(const Args& a, int l, int first, LAS unsigned char* lds) {
    int tid_ = threadIdx.x; asm volatile("" : "+v"(tid_)); const int tid = tid_, lane = tid & 63, wave = tid >> 6;
    const int G = gridDim.x, nb = G - first, me = (int)blockIdx.x - first;
    if (me < 0 || nb <= 0) return;
    LAS float* scr = (LAS float*)(lds + wave * 8704);
    constexpr int I_IN = (DM / 64) * (PW / 32), I_OUT = (DM / 64) * (DM / 32);
    const int li = l + 1, n_in = (li < DEPTH) ? I_IN : 0;
    bf16* Win_t = (bf16*)(a.ws + WS_WIN) + (size_t)li * PW * DM; bf16* Wout_t = (bf16*)(a.ws + WS_WOUT) + (size_t)l * DM * DM;
    for (int it = me * 8 + wave; it < I_OUT + n_in; it += nb * 8) {
        if (it < I_OUT) transpose_item(a.in[15] + (size_t)l * DM * DM, DM, DM, Wout_t, nullptr, scr, it, lane);
        else transpose_item(a.in[9] + (size_t)li * DM * PW, DM, PW, Win_t, a.in[8] + li * DM, scr, it - I_OUT, lane);
    }
}

constexpr int H1_QT = 0, H1_KP = H1_QT + 4352, H1_KBT = H1_KP + 4352, H1_VT = H1_KBT + 5120, H1_DS = H1_VT + 5120, H1_BUF = H1_DS + 512, H1_TROW = 20;
__device__ __forceinline__ void hg_pass1(const Args& a, int layer, int unit, LAS unsigned char* lds) {
    int tid_ = threadIdx.x; asm volatile("" : "+v"(tid_)); const int tid = tid_, lane = tid & 63, wave = tid >> 6, l15 = lane & 15, quad = lane >> 4;
    const int b = unit / (HGH * NSC), h = (unit / NSC) % HGH, sc = unit % NSC;
    const int nsub = (sc == NSC - 1) ? 17 : 16;
    const int tg = quad, k = 16 * wave + l15;
    const bf16* P = (const bf16*)(a.ws + WS_P);
    const float lb = ((const float*)(a.ws + WS_LB))[layer * 512 + h * 128 + k];
    const size_t row0 = (size_t)b * LP + (size_t)sc * 256;
    float gacc = 0.f;
    f32x4 S[8];
#pragma unroll
    for (int kt = 0; kt < 8; ++kt) S[kt] = (f32x4){0.f, 0.f, 0.f, 0.f};
    unsigned short zn[4], qn[4], vn[4];
    { const bf16* pn = P + (row0 + 4 * tg) * PW + h * 128 + k;
#pragma unroll
      for (int e = 0; e < 4; ++e) { zn[e] = pn[e * PW + C_FH]; qn[e] = pn[e * PW + C_QH]; vn[e] = pn[e * PW + C_IH]; } }
    bf16* QH = (bf16*)(a.ws + WS_QH) + (row0 + 4 * tg) * 512 + h * 128 + k;
    for (int i = 0; i < nsub; ++i) {
        LAS unsigned char* buf = lds + (i & 1) * H1_BUF;
        float z[4], q[4]; unsigned short vr[4];
#pragma unroll
        for (int e = 0; e < 4; ++e) { z[e] = bf2f(zn[e]); q[e] = bf2f(qn[e]); vr[e] = vn[e]; }
        if (i + 1 < nsub) { const bf16* pn = P + (row0 + 16 * (i + 1) + 4 * tg) * PW + h * 128 + k;
#pragma unroll
            for (int e = 0; e < 4; ++e) { zn[e] = pn[e * PW + C_FH]; qn[e] = pn[e * PW + C_QH]; vn[e] = pn[e * PW + C_IH]; } }
        float c[4], kk[4], qs[4];
#pragma unroll
        for (int e = 0; e < 4; ++e) {
            const float sig = __builtin_amdgcn_rcpf(1.f + __expf(-z[e]));
            const float f = lb + (1.f - lb) * sig;
            c[e] = __logf(fmaxf(f, 1e-30f)); kk[e] = (1.f - lb) * (1.f - sig); qs[e] = silu_f(q[e]);
        }
        c[1] += c[0]; c[2] += c[1]; c[3] += c[2];
        const float T = c[3];
        float sincl = T, x = __shfl_up(sincl, 16);
        if (tg >= 1) sincl += x;
        x = __shfl_up(sincl, 32);
        if (tg >= 2) sincl += x;
        const float off = sincl - T, ce = __shfl(sincl, 48 + l15);
        float qt[4], kp[4], kb[4], qh[4];
        const float egacc = __expf(gacc);
#pragma unroll
        for (int e = 0; e < 4; ++e) {
            const float ct = off + c[e];
            qt[e] = qs[e] * __expf(ct); kp[e] = kk[e] * __expf(fminf(-ct, 80.f)); kb[e] = kk[e] * __expf(ce - ct); qh[e] = qt[e] * egacc;
        }
        const unsigned qt01 = pk2(qt[0], qt[1]), qt23 = pk2(qt[2], qt[3]), kp01 = pk2(kp[0], kp[1]), kp23 = pk2(kp[2], kp[3]), qh01 = pk2(qh[0], qh[1]), qh23 = pk2(qh[2], qh[3]);
        LAS unsigned short* qtp = (LAS unsigned short*)(buf + H1_QT) + (4 * tg) * 136 + k;
        qtp[0] = (unsigned short)qt01; qtp[136] = (unsigned short)(qt01 >> 16); qtp[272] = (unsigned short)qt23; qtp[408] = (unsigned short)(qt23 >> 16);
        LAS unsigned short* kpp = (LAS unsigned short*)(buf + H1_KP) + (4 * tg) * 136 + k;
        kpp[0] = (unsigned short)kp01; kpp[136] = (unsigned short)(kp01 >> 16); kpp[272] = (unsigned short)kp23; kpp[408] = (unsigned short)(kp23 >> 16);
        *(LAS u32x2*)(buf + H1_KBT + (k * H1_TROW + 4 * tg) * 2) = (u32x2){pk2(kb[0], kb[1]), pk2(kb[2], kb[3])};
        *(LAS u32x2*)(buf + H1_VT + (k * H1_TROW + 4 * tg) * 2) = (u32x2){(unsigned)vr[0] | ((unsigned)vr[1] << 16), (unsigned)vr[2] | ((unsigned)vr[3] << 16)};
        if (tg == 0) *(LAS float*)(buf + H1_DS + k * 4) = __expf(ce);
        if (i < 8) { LAS unsigned short* ql = (LAS unsigned short*)(lds + QLDS_OFF + (16 * i + 4 * tg) * QLDS_ROW) + k;
            ql[0] = (unsigned short)qh01; ql[QLDS_ROW / 2] = (unsigned short)(qh01 >> 16); ql[QLDS_ROW] = (unsigned short)qh23; ql[3 * QLDS_ROW / 2] = (unsigned short)(qh23 >> 16); }
        else
        { bf16* qo = QH + (size_t)(16 * i) * 512; qo[0] = (bf16)qh01; qo[512] = (bf16)(qh01 >> 16); qo[1024] = (bf16)qh23; qo[1536] = (bf16)(qh23 >> 16); }
        gacc += ce;
        __syncthreads();
        f32x4 at = {0.f, 0.f, 0.f, 0.f};
#pragma unroll
        for (int kq = 0; kq < 4; ++kq) {
            const s16x8 ka = *(const LAS s16x8*)(buf + H1_KP + (l15 * 136 + quad * 8 + 32 * kq) * 2);
            const s16x8 qb = *(const LAS s16x8*)(buf + H1_QT + (l15 * 136 + quad * 8 + 32 * kq) * 2);
            at = MFMA32(ka, qb, at);
        }
#pragma unroll
        for (int j = 0; j < 4; ++j) if (quad * 4 + j > l15) at[j] = 0.f;
        const u32x2 ptu = {pk2(at[0], at[1]), pk2(at[2], at[3])};
        const s16x4 pt = __builtin_bit_cast(s16x4, ptu);
        const s16x4 vf = *(const LAS s16x4*)(buf + H1_VT + ((16 * wave + l15) * H1_TROW + quad * 4) * 2);
        f32x4 o = {0.f, 0.f, 0.f, 0.f};
#pragma unroll
        for (int kq = 0; kq < 4; ++kq) {
            const u32x4 sau = {pk2(S[2 * kq][0], S[2 * kq][1]), pk2(S[2 * kq][2], S[2 * kq][3]), pk2(S[2 * kq + 1][0], S[2 * kq + 1][1]), pk2(S[2 * kq + 1][2], S[2 * kq + 1][3])};
            const s16x8 sa = __builtin_bit_cast(s16x8, sau);
            const u32x2 q0 = *(const LAS u32x2*)(buf + H1_QT + (l15 * 136 + 32 * kq + quad * 4) * 2);
            const u32x2 q1 = *(const LAS u32x2*)(buf + H1_QT + (l15 * 136 + 32 * kq + 16 + quad * 4) * 2);
            const u32x4 qbu = {q0.x, q0.y, q1.x, q1.y};
            o = MFMA32(sa, __builtin_bit_cast(s16x8, qbu), o);
        }
        MFMA_DRAIN();
        o = MFMA16(vf, pt, o);
        *(LAS u32x2*)(lds + OLDS_OFF + (16 * i + l15) * OLDS_ROW + (16 * wave + quad * 4) * 2) = (u32x2){pk2(o[0], o[1]), pk2(o[2], o[3])};
#pragma unroll
        for (int kt = 0; kt < 8; ++kt) {
            const f32x4 d = *(const LAS f32x4*)(buf + H1_DS + (16 * kt + quad * 4) * 4);
            const s16x4 ka = *(const LAS s16x4*)(buf + H1_KBT + ((16 * kt + l15) * H1_TROW + quad * 4) * 2);
            S[kt] = MFMA16(ka, vf, S[kt] * d);
        }
    }
    float* L = (float*)(a.ws + WS_L) + (size_t)((b * HGH + h) * NSC + sc) * 16384;
#pragma unroll
    for (int kt = 0; kt < 8; ++kt) *(f32x4*)(L + (16 * wave + l15) * 128 + 16 * kt + quad * 4) = S[kt];
    if (tg == 0) ((float*)(a.ws + WS_D))[((b * HGH + h) * NSC + sc) * 128 + k] = __expf(gacc);
    __syncthreads();
}

__device__ __forceinline__ void hg_scan(const Args& a, int layer) {
    const int G = gridDim.x;
    int tid_ = threadIdx.x; asm volatile("" : "+v"(tid_));
    for (int e = blockIdx.x * NTHREADS + tid_; e < NB * HGH * HK * HV; e += G * NTHREADS) {
        const int bh = e >> 14, kv = e & 16383, k = kv & 127, v = kv >> 7;
        const float* L = (const float*)(a.ws + WS_L) + (size_t)bh * NSC * 16384 + kv; const float* D = (const float*)(a.ws + WS_D) + bh * NSC * 128 + k;
        float l[NSC], d[NSC];
#pragma unroll
        for (int s = 0; s < NSC; ++s) { l[s] = __builtin_nontemporal_load(L + (size_t)s * 16384); d[s] = D[s * 128]; }
        float S = 0.f;
        bf16* Sst = (bf16*)(a.ws + WS_S) + (size_t)bh * NSC * 16384 + kv;
#pragma unroll
        for (int s = 0; s < NSC; ++s) { Sst[(size_t)s * 16384] = (bf16)pk2(S, S); S = d[s] * S + l[s]; }
        const int b = bh >> 2, h = bh & 3;
        a.out[O_HP + (size_t)((b * DEPTH + layer) * HGH + h) * 16384 + k * 128 + v] = S;
    }
}

__device__ __forceinline__ void hg_sample(const Args& a, int layer, int unit, LAS unsigned char* lds) {
    int tid_ = threadIdx.x; asm volatile("" : "+v"(tid_)); const int tid = tid_, lane = tid & 63, wave = tid >> 6;
    const int seq = unit >> 2, h = unit & 3;
    const int v4 = (tid & 31) * 4, kg = tid >> 5;
    const bf16* prow = (const bf16*)(a.ws + WS_P) + (size_t)(MP + seq) * PW + h * 128;
    const float* lbp = (const float*)(a.ws + WS_LB) + layer * 512 + h * 128 + kg * 8;
    const u32x4 zz = *(const u32x4*)(prow + C_FH + kg * 8), qq = *(const u32x4*)(prow + C_QH + kg * 8);
    const u32x2 vv = *(const u32x2*)(prow + C_IH + v4);
    const float z[8] = {bflo(zz.x), bfhi(zz.x), bflo(zz.y), bfhi(zz.y), bflo(zz.z), bfhi(zz.z), bflo(zz.w), bfhi(zz.w)};
    const float q[8] = {bflo(qq.x), bfhi(qq.x), bflo(qq.y), bfhi(qq.y), bflo(qq.z), bfhi(qq.z), bflo(qq.w), bfhi(qq.w)};
    const f32x4 v = {bflo(vv.x), bfhi(vv.x), bflo(vv.y), bfhi(vv.y)};
    const size_t sidx = (size_t)((seq * DEPTH + layer) * HGH + h) * 16384;
    const float* S0 = a.in[6] + sidx; float* S1 = a.out + O_HS + sidx;
    f32x4 o = {0.f, 0.f, 0.f, 0.f};
#pragma unroll
    for (int i = 0; i < 8; ++i) {
        const float lbv = lbp[i];
        const float sig = 1.f / (1.f + __expf(-z[i])), sigm = 1.f / (1.f + __expf(z[i]));
        const float f = fmaxf(lbv + (1.f - lbv) * sig, 1e-30f), kk = (1.f - lbv) * sigm, qs = silu_f(q[i]);
        const int k = kg * 8 + i;
        const f32x4 s0 = __builtin_nontemporal_load((const f32x4*)(S0 + k * 128 + v4));
        const f32x4 s1 = s0 * f + v * kk;
        __builtin_nontemporal_store(s1, (f32x4*)(S1 + k * 128 + v4));
        o += s1 * qs;
    }
    LAS float* red = (LAS float*)lds;
    LAS float* red2 = (LAS float*)(lds + 8192);
    *(LAS f32x4*)(red + kg * 128 + v4) = o;
    __syncthreads();
    float ov = 0.f;
    if (tid < 128) {
#pragma unroll
        for (int g = 0; g < 16; ++g) ov += red[g * 128 + tid];
        const float ssq = wave_sum(ov * ov);
        if (lane == 0) red2[wave] = ssq;
    }
    __syncthreads();
    if (tid < 128) {
        const float rs = rsqrtf((red2[0] + red2[1]) * (1.f / HV) + EPS);
        const float gh = bf2f(prow[C_GH + tid]);
        bf16* MIX = (bf16*)(a.ws + WS_MIX);
        MIX[(size_t)(MP + seq) * DM + 512 + h * 128 + tid] = (bf16)f2bf(ov * rs * a.in[14][layer * HV + tid] * silu_f(gh));
    }
    __syncthreads();
}


__device__ __forceinline__ void hg_sample2(const Args& a, int layer, int u0, int u1, LAS unsigned char* lds) {
    int tid_ = threadIdx.x; asm volatile("" : "+v"(tid_)); const int tid = tid_, lane = tid & 63, wave = tid >> 6;
    const int v4 = (tid & 31) * 4, kg = tid >> 5;
    const int uu[2] = {u0, u1};
    u32x4 zz[2], qq[2]; u32x2 vv[2]; f32x4 s0[2][8]; float lbv[8];
    const bf16* prow[2]; const float* S0p[2]; float* S1p[2];
#pragma unroll
    for (int t = 0; t < 2; ++t) {
        const int seq = uu[t] >> 2, h = uu[t] & 3;
        prow[t] = (const bf16*)(a.ws + WS_P) + (size_t)(MP + seq) * PW + h * 128;
        zz[t] = *(const u32x4*)(prow[t] + C_FH + kg * 8); qq[t] = *(const u32x4*)(prow[t] + C_QH + kg * 8); vv[t] = *(const u32x2*)(prow[t] + C_IH + v4);
        const size_t sidx = (size_t)((seq * DEPTH + layer) * HGH + h) * 16384;
        S0p[t] = a.in[6] + sidx; S1p[t] = a.out + O_HS + sidx;
#pragma unroll
        for (int i = 0; i < 8; ++i) s0[t][i] = __builtin_nontemporal_load((const f32x4*)(S0p[t] + (kg * 8 + i) * 128 + v4));
    }
    LAS float* red = (LAS float*)lds;
    LAS float* red2 = (LAS float*)(lds + 16384);
#pragma unroll
    for (int t = 0; t < 2; ++t) {
        const int h = uu[t] & 3;
        const float* lbp = (const float*)(a.ws + WS_LB) + layer * 512 + h * 128 + kg * 8;
        const float z[8] = {bflo(zz[t].x), bfhi(zz[t].x), bflo(zz[t].y), bfhi(zz[t].y), bflo(zz[t].z), bfhi(zz[t].z), bflo(zz[t].w), bfhi(zz[t].w)};
        const float q[8] = {bflo(qq[t].x), bfhi(qq[t].x), bflo(qq[t].y), bfhi(qq[t].y), bflo(qq[t].z), bfhi(qq[t].z), bflo(qq[t].w), bfhi(qq[t].w)};
        const f32x4 v = {bflo(vv[t].x), bfhi(vv[t].x), bflo(vv[t].y), bfhi(vv[t].y)};
        f32x4 o = {0.f, 0.f, 0.f, 0.f};
#pragma unroll
        for (int i = 0; i < 8; ++i) {
            const float lb1 = lbp[i];
            const float sig = 1.f / (1.f + __expf(-z[i])), sigm = 1.f / (1.f + __expf(z[i]));
            const float f = fmaxf(lb1 + (1.f - lb1) * sig, 1e-30f), kk = (1.f - lb1) * sigm, qs = silu_f(q[i]);
            const f32x4 s1 = s0[t][i] * f + v * kk;
            __builtin_nontemporal_store(s1, (f32x4*)(S1p[t] + (kg * 8 + i) * 128 + v4));
            o += s1 * qs;
        }
        *(LAS f32x4*)(red + t * 2048 + kg * 128 + v4) = o;
    }
    __syncthreads();
    float ov = 0.f; const int t2 = tid >> 7, vi = tid & 127;
    if (tid < 256) {
#pragma unroll
        for (int g = 0; g < 16; ++g) ov += red[t2 * 2048 + g * 128 + vi];
        const float ssq = wave_sum(ov * ov);
        if (lane == 0) red2[wave] = ssq;
    }
    __syncthreads();
    if (tid < 256) {
        const int seq = uu[t2] >> 2, h = uu[t2] & 3;
        const float rs = rsqrtf((red2[2 * t2] + red2[2 * t2 + 1]) * (1.f / HV) + EPS);
        const float gh = bf2f(prow[t2][C_GH + vi]);
        bf16* MIX = (bf16*)(a.ws + WS_MIX);
        MIX[(size_t)(MP + seq) * DM + 512 + h * 128 + vi] = (bf16)f2bf(ov * rs * a.in[14][layer * HV + vi] * silu_f(gh));
    }
    __syncthreads();
}
struct P2Tile { s16x8 bq[4]; u32x2 ggv[8]; };
__device__ __forceinline__ void p2_load(P2Tile& T, const bf16* P, const bf16* QH, const bf16* OL, size_t row, int h, int quad, LAS unsigned char* qlds = nullptr, int lrow = 0) {
    const bf16* prow = P + row * PW + h * 128;
    if (qlds) {
#pragma unroll
        for (int kq = 0; kq < 4; ++kq) T.bq[kq] = *(const LAS s16x8*)(qlds + lrow * QLDS_ROW + (quad * 8 + 32 * kq) * 2);
    } else
#pragma unroll
    for (int kq = 0; kq < 4; ++kq) T.bq[kq] = __builtin_nontemporal_load((const s16x8*)(QH + row * 512 + h * 128 + quad * 8 + 32 * kq));
#pragma unroll
    for (int vt = 0; vt < 8; ++vt) {
        T.ggv[vt] = *(const u32x2*)(prow + C_GH + 16 * vt + quad * 4); }
}
__device__ __forceinline__ void p2_compute(const P2Tile& T, const Args& a, int layer, bf16* MIX, LAS unsigned char* lds, size_t row, int lrow, int h, int l15, int quad) {
    f32x4 o[8]; float ssq = 0.f;
#pragma unroll
    for (int vt = 0; vt < 8; ++vt) {
        f32x4 acc = {0.f, 0.f, 0.f, 0.f};
#pragma unroll
        for (int kq = 0; kq < 4; ++kq) { const s16x8 sa = *(const LAS s16x8*)(lds + ((16 * vt + l15) * 136 + quad * 8 + 32 * kq) * 2); acc = MFMA32(sa, T.bq[kq], acc); }
        const u32x2 ol = *(const LAS u32x2*)(lds + OLDS_OFF + lrow * OLDS_ROW + (16 * vt + quad * 4) * 2);
        acc += (f32x4){bflo(ol.x), bfhi(ol.x), bflo(ol.y), bfhi(ol.y)};
        o[vt] = acc; ssq += acc[0] * acc[0] + acc[1] * acc[1] + acc[2] * acc[2] + acc[3] * acc[3];
        if ((vt & 3) == 3) __builtin_amdgcn_sched_barrier(0);
    }
    ssq += __shfl_xor(ssq, 16); ssq += __shfl_xor(ssq, 32);
    const float rs = rsqrtf(ssq * (1.f / HV) + EPS);
#pragma unroll
    for (int vt = 0; vt < 8; ++vt) {
        const u32x2 gg = T.ggv[vt];
        const f32x4 w = *(const f32x4*)(a.in[14] + layer * HV + 16 * vt + quad * 4);
        const float r0 = o[vt][0] * rs * w[0] * silu_f(bflo(gg.x)), r1 = o[vt][1] * rs * w[1] * silu_f(bfhi(gg.x)), r2 = o[vt][2] * rs * w[2] * silu_f(bflo(gg.y)), r3 = o[vt][3] * rs * w[3] * silu_f(bfhi(gg.y));
        *(u32x2*)(MIX + row * DM + 512 + h * 128 + 16 * vt + quad * 4) = (u32x2){pk2(r0, r1), pk2(r2, r3)};
    }
}
__device__ __forceinline__ void hg_pass2(const Args& a, int layer, int unit, LAS unsigned char* lds) {
    int tid_ = threadIdx.x; asm volatile("" : "+v"(tid_)); const int tid = tid_, lane = tid & 63, wave = tid >> 6, l15 = lane & 15, quad = lane >> 4;
    const int b = unit / (HGH * NSC), h = (unit / NSC) % HGH, sc = unit % NSC;
    const int nsub = (sc == NSC - 1) ? 17 : 16;
    const size_t row0 = (size_t)b * LP + (size_t)sc * 256;
    const bf16* P = (const bf16*)(a.ws + WS_P); bf16* MIX = (bf16*)(a.ws + WS_MIX);
    const bf16* Sst = (const bf16*)(a.ws + WS_S) + (size_t)((b * HGH + h) * NSC + sc) * 16384;
    const bf16* QH = (const bf16*)(a.ws + WS_QH); const bf16* OL = (const bf16*)(a.ws + WS_OL);
    u32x4 sv[4];
#pragma unroll
    for (int j = 0; j < 4; ++j) { const int idx = tid + NTHREADS * j, v = idx >> 4, k8 = (idx & 15) * 8; sv[j] = __builtin_nontemporal_load((const u32x4*)(Sst + v * 128 + k8)); }
    const size_t rowA = row0 + 16 * wave + l15, rowB = rowA + 128;
    P2Tile TA, TB;
    p2_load(TA, P, QH, OL, rowA, h, quad, lds + QLDS_OFF, 16 * wave + l15);
    p2_load(TB, P, QH, OL, rowB, h, quad);
#pragma unroll
    for (int j = 0; j < 4; ++j) { const int idx = tid + NTHREADS * j, v = idx >> 4, k8 = (idx & 15) * 8;
        *(LAS u32x4*)(lds + (v * 136 + k8) * 2) = sv[j]; }
    __syncthreads();
    p2_compute(TA, a, layer, MIX, lds, rowA, 16 * wave + l15, h, l15, quad);
    p2_compute(TB, a, layer, MIX, lds, rowB, 16 * wave + l15 + 128, h, l15, quad);
    if (wave + 16 < nsub) {
        const size_t rowC = rowA + 256;
        p2_load(TA, P, QH, OL, rowC, h, quad);
        p2_compute(TA, a, layer, MIX, lds, rowC, 16 * wave + l15 + 256, h, l15, quad);
    }
    __syncthreads();
}

constexpr int PA_KROW = 72, PA_V = 272 * PA_KROW * 2, PA_VROW = 280;
constexpr int PA_VR = 160;
__device__ __forceinline__ void pattn(const Args& a, int layer, int unit, LAS unsigned char* lds) {
    int tid_ = threadIdx.x; asm volatile("" : "+v"(tid_)); const int tid = tid_, lane = tid & 63, wave = tid >> 6, l15 = lane & 15, quad = lane >> 4;
    int b, nb; const int kvh = unit & 1;
    if (unit < 256) { b = unit >> 7; nb = (unit >> 1) & 63; } else { b = (unit - 256) >> 1; nb = 64; }
    const bf16* P = (const bf16*)(a.ws + WS_P); bf16* MIX = (bf16*)(a.ws + WS_MIX);
    const float* knw = a.in[11] + layer * HD; const float* qnw = a.in[10] + layer * HD;
    u32x4 kxa[5], vxa[5];
#pragma unroll
    for (int j = 0; j < 5; ++j) {
        const int it = tid + NTHREADS * j, kr = it >> 3, c8 = it & 7;
        const int pos = kr < 16 ? kr : (nb - 1) * 128 + (kr - 16);
        const bool valid = (kr < 272) && pos >= 0 && pos < LP;
        const size_t row = (size_t)b * LP + pos;
        kxa[j] = (u32x4){0u, 0u, 0u, 0u}; vxa[j] = (u32x4){0u, 0u, 0u, 0u};
        if (valid) { kxa[j] = *(const u32x4*)(P + row * PW + C_KA + kvh * 64 + c8 * 8); vxa[j] = *(const u32x4*)(P + row * PW + C_VA + kvh * 64 + c8 * 8); }
    }
    u32x4 qn0 = {0u, 0u, 0u, 0u}, qn1 = {0u, 0u, 0u, 0u};
    { const int qt = wave * 4, g = qt >> 3, r0 = (qt & 7) * 16, p = nb * 128 + r0 + l15;
      if (p < LP) { const bf16* qp = P + ((size_t)b * LP + p) * PW + C_QA + (kvh * 4 + g) * 64 + quad * 8; qn0 = *(const u32x4*)qp; qn1 = *(const u32x4*)(qp + 32); } }
#pragma unroll
    for (int j = 0; j < 5; ++j) {
        const int it = tid + NTHREADS * j, kr = it >> 3, c8 = it & 7;
        const int pos = kr < 16 ? kr : (nb - 1) * 128 + (kr - 16);
        const bool valid = (kr < 272) && pos >= 0 && pos < LP;
        const u32x4 kx = kxa[j], vx = vxa[j];
        float kf[8] = {bflo(kx.x), bfhi(kx.x), bflo(kx.y), bfhi(kx.y), bflo(kx.z), bfhi(kx.z), bflo(kx.w), bfhi(kx.w)};
        float ssq = 0.f;
#pragma unroll
        for (int e = 0; e < 8; ++e) ssq += kf[e] * kf[e];
        ssq += __shfl_xor(ssq, 1); ssq += __shfl_xor(ssq, 2); ssq += __shfl_xor(ssq, 4);
        const float rs = rsqrtf(ssq * (1.f / HD) + EPS);
        const f32x4 w0 = *(const f32x4*)(knw + c8 * 8), w1 = *(const f32x4*)(knw + c8 * 8 + 4);
        kf[0] *= rs * w0[0]; kf[1] *= rs * w0[1]; kf[2] *= rs * w0[2]; kf[3] *= rs * w0[3]; kf[4] *= rs * w1[0]; kf[5] *= rs * w1[1]; kf[6] *= rs * w1[2]; kf[7] *= rs * w1[3];
        if (kr < 272) {
            *(LAS u32x4*)(lds + (kr * PA_KROW + c8 * 8) * 2) = (u32x4){pk2(kf[0], kf[1]), pk2(kf[2], kf[3]), pk2(kf[4], kf[5]), pk2(kf[6], kf[7])};
            *(LAS u32x4*)(lds + PA_V + kr * PA_VR + c8 * 16) = vx;
        }
        if (valid) {
            float* ok = nullptr; float* ov = nullptr;
            if (nb == 0 && kr < 16) { const size_t o = ((size_t)((b * DEPTH + layer) * NMETA + kr) * NKV + kvh) * HD + c8 * 8; ok = a.out + O_MKP + o; ov = a.out + O_MVP + o; }
            else if (kr >= 144 && pos >= LP - WIN) { const size_t o = ((size_t)((b * DEPTH + layer) * WIN + (pos - (LP - WIN))) * NKV + kvh) * HD + c8 * 8; ok = a.out + O_WKP + o; ov = a.out + O_WVP + o; }
            if (ok) {
                *(f32x4*)ok = (f32x4){kf[0], kf[1], kf[2], kf[3]}; *(f32x4*)(ok + 4) = (f32x4){kf[4], kf[5], kf[6], kf[7]};
                *(f32x4*)ov = (f32x4){bflo(vx.x), bfhi(vx.x), bflo(vx.y), bfhi(vx.y)}; *(f32x4*)(ov + 4) = (f32x4){bflo(vx.z), bfhi(vx.z), bflo(vx.w), bfhi(vx.w)};
            }
        }
    }
    __syncthreads();
    const int nq = (nb == 64) ? 1 : 8;
#pragma unroll 1
    for (int i = 0; i < 4; ++i) {
        const int qt = wave * 4 + i, g = qt >> 3, tb = qt & 7, r0 = tb * 16, head = kvh * 4 + g;
        const int p = nb * 128 + r0 + l15; const bool qvalid = p < LP; const size_t row = (size_t)b * LP + p;
        const u32x4 qx0 = qn0, qx1 = qn1;
        if (i < 3) {
            const int qt2 = qt + 1, g2 = qt2 >> 3, p2 = nb * 128 + (qt2 & 7) * 16 + l15;
            qn0 = (u32x4){0u, 0u, 0u, 0u}; qn1 = (u32x4){0u, 0u, 0u, 0u};
            if (p2 < LP) { const bf16* qp = P + ((size_t)b * LP + p2) * PW + C_QA + (kvh * 4 + g2) * 64 + quad * 8; qn0 = *(const u32x4*)qp; qn1 = *(const u32x4*)(qp + 32); }
        }
        if (tb >= nq) continue;
        u32x2 gg[4];
#pragma unroll
        for (int dt = 0; dt < 4; ++dt) { gg[dt] = (u32x2){0u, 0u}; if (qvalid) gg[dt] = *(const u32x2*)(P + row * PW + C_GA + head * 64 + 16 * dt + quad * 4); }
        const float sink = a.in[12][layer * NQH + head] * 1.4426950408889634f;
        float qf[16] = {bflo(qx0.x), bfhi(qx0.x), bflo(qx0.y), bfhi(qx0.y), bflo(qx0.z), bfhi(qx0.z), bflo(qx0.w), bfhi(qx0.w),
                        bflo(qx1.x), bfhi(qx1.x), bflo(qx1.y), bfhi(qx1.y), bflo(qx1.z), bfhi(qx1.z), bflo(qx1.w), bfhi(qx1.w)};
        float ssq = 0.f;
#pragma unroll
        for (int e = 0; e < 16; ++e) ssq += qf[e] * qf[e];
        ssq += __shfl_xor(ssq, 16); ssq += __shfl_xor(ssq, 32);
        const float rs = rsqrtf(ssq * (1.f / HD) + EPS) * (0.125f * 1.4426950408889634f);
        s16x8 bq[2];
#pragma unroll
        for (int kq = 0; kq < 2; ++kq) {
            const f32x4 w0 = *(const f32x4*)(qnw + quad * 8 + 32 * kq), w1 = *(const f32x4*)(qnw + quad * 8 + 32 * kq + 4);
            const u32x4 pk = {pk2(qf[kq * 8 + 0] * rs * w0[0], qf[kq * 8 + 1] * rs * w0[1]), pk2(qf[kq * 8 + 2] * rs * w0[2], qf[kq * 8 + 3] * rs * w0[3]),
                              pk2(qf[kq * 8 + 4] * rs * w1[0], qf[kq * 8 + 5] * rs * w1[1]), pk2(qf[kq * 8 + 6] * rs * w1[2], qf[kq * 8 + 7] * rs * w1[3])};
            bq[kq] = __builtin_bit_cast(s16x8, pk);
        }
        LAS unsigned char* kb0 = lds + (l15 * PA_KROW + quad * 8) * 2;
        LAS unsigned char* kbt = kb0 + tb * (16 * PA_KROW * 2);
        f32x4 at[10];
#pragma unroll
        for (int r = 0; r < 10; ++r) {
            f32x4 acc = {0.f, 0.f, 0.f, 0.f};
            LAS unsigned char* kp = (r == 0) ? kb0 : kbt + r * (16 * PA_KROW * 2);
#pragma unroll
            for (int kq = 0; kq < 2; ++kq) { const s16x8 ka = *(const LAS s16x8*)(kp + kq * 64); acc = MFMA32(ka, bq[kq], acc); }
            at[r] = acc;
        }
        const int lo_b = 32 - (nb - 1) * 128 - 16 * tb;
        const int lor = ((l15 + 17 > lo_b) ? l15 + 17 : lo_b) - quad * 4, hir = 144 + l15 - quad * 4, pmr = (p < 15 ? p : 15) - quad * 4;
        float mx = -1e30f;
#pragma unroll
        for (int r = 0; r < 10; ++r) {
            if (r >= 2 && r <= 8 && nb >= 1) {
#pragma unroll
                for (int j = 0; j < 4; ++j) mx = fmaxf(mx, at[r][j]);
            } else {
#pragma unroll
                for (int j = 0; j < 4; ++j) {
                    const int c = 16 * r + j;
                    const bool vis = (r == 0) ? (c <= pmr) : (c >= lor && c <= hir);
                    const float s = vis ? at[r][j] : -1e30f; at[r][j] = s; mx = fmaxf(mx, s);
                }
            }
        }
        mx = fmaxf(mx, __shfl_xor(mx, 16)); mx = fmaxf(mx, __shfl_xor(mx, 32));
        const float m = fmaxf(mx, sink);
        float sum = 0.f;
#pragma unroll
        for (int r = 0; r < 10; ++r) {
#pragma unroll
            for (int j = 0; j < 4; ++j) { const float e = __builtin_amdgcn_exp2f(at[r][j] - m); at[r][j] = e; sum += e; }
        }
        sum += __shfl_xor(sum, 16); sum += __shfl_xor(sum, 32);
        const float inv = 1.f / (sum + __builtin_amdgcn_exp2f(sink - m));
        f32x4 ot[4];
#pragma unroll
        for (int dt = 0; dt < 4; ++dt) ot[dt] = (f32x4){0.f, 0.f, 0.f, 0.f};
        LAS unsigned char* vb0 = lds + PA_V + (quad * 4 + (l15 >> 2)) * PA_VR + (l15 & 3) * 8;
        LAS unsigned char* vbt = vb0 + tb * (16 * PA_VR);
#pragma unroll
        for (int r = 0; r < 10; ++r) {
            const u32x2 pp = {pk2(at[r][0], at[r][1]), pk2(at[r][2], at[r][3])};
            const s16x4 pt = __builtin_bit_cast(s16x4, pp);
            LAS unsigned char* vp = (r == 0) ? vb0 : vbt + r * (16 * PA_VR);
#pragma unroll
            for (int dt = 0; dt < 4; ++dt) { const s16x4 va = __builtin_amdgcn_ds_read_tr16_b64_v4i16((LAS s16x4*)(vp + dt * 32)); ot[dt] = MFMA16(va, pt, ot[dt]); }
        }
        if (qvalid) {
#pragma unroll
            for (int dt = 0; dt < 4; ++dt) {
                const int d = 16 * dt + quad * 4;
                const float r0v = ot[dt][0] * inv * silu_f(bflo(gg[dt].x)), r1v = ot[dt][1] * inv * silu_f(bfhi(gg[dt].x)), r2v = ot[dt][2] * inv * silu_f(bflo(gg[dt].y)), r3v = ot[dt][3] * inv * silu_f(bfhi(gg[dt].y));
                *(u32x2*)(MIX + row * DM + head * 64 + d) = (u32x2){pk2(r0v, r1v), pk2(r2v, r3v)};
            }
        }
    }
    __syncthreads();
}

constexpr int SA_ROW = 136, SA_K = 0, SA_V = 39936, SA_Q = 79872, SA_P = 81920;
__device__ __forceinline__ void sattn(const Args& a, int layer, int seq, LAS unsigned char* lds) {
    int tid_ = threadIdx.x; asm volatile("" : "+v"(tid_)); const int tid = tid_, lane = tid & 63, wave = tid >> 6;
    const size_t cidx = (size_t)(seq * DEPTH + layer) * WIN * 128, midx = (size_t)(seq * DEPTH + layer) * NMETA * 128;
    const float* ck = a.in[2] + cidx; const float* cv = a.in[3] + cidx; const float* mk = a.in[4] + midx; const float* mv = a.in[5] + midx;
    float* ok = a.out + O_WKS + cidx; float* ov = a.out + O_WVS + cidx;
    const size_t row = MP + seq;
    const bf16* prow = (const bf16*)(a.ws + WS_P) + row * PW;
#pragma unroll
    for (int j = 0; j < 8; ++j) {
        const int idx = tid + NTHREADS * j, r = idx >> 5, c4 = (idx & 31) * 4;
        const f32x4 kx = *(const f32x4*)(ck + r * 128 + c4), vx = *(const f32x4*)(cv + r * 128 + c4);
        if (r >= 1) { *(f32x4*)(ok + (r - 1) * 128 + c4) = kx; *(f32x4*)(ov + (r - 1) * 128 + c4) = vx; }
        *(LAS u32x2*)(lds + SA_K + ((16 + r) * SA_ROW + c4) * 2) = (u32x2){pk2(kx[0], kx[1]), pk2(kx[2], kx[3])};
        *(LAS u32x2*)(lds + SA_V + ((16 + r) * SA_ROW + c4) * 2) = (u32x2){pk2(vx[0], vx[1]), pk2(vx[2], vx[3])};
    }
    { const int r = tid >> 5, c4 = (tid & 31) * 4;
      const f32x4 kx = *(const f32x4*)(mk + r * 128 + c4), vx = *(const f32x4*)(mv + r * 128 + c4);
      *(LAS u32x2*)(lds + SA_K + (r * SA_ROW + c4) * 2) = (u32x2){pk2(kx[0], kx[1]), pk2(kx[2], kx[3])};
      *(LAS u32x2*)(lds + SA_V + (r * SA_ROW + c4) * 2) = (u32x2){pk2(vx[0], vx[1]), pk2(vx[2], vx[3])}; }
    if (wave == 0) {
        const int kvh = lane >> 5, d2 = (lane & 31) * 2;
        const unsigned kk2 = *(const unsigned*)(prow + C_KA + kvh * 64 + d2);
        const float k0 = bflo(kk2), k1 = bfhi(kk2);
        float ssq = k0 * k0 + k1 * k1;
#pragma unroll
        for (int o = 1; o < 32; o <<= 1) ssq += __shfl_xor(ssq, o);
        const float rs = rsqrtf(ssq * (1.f / HD) + EPS);
        const float n0 = k0 * rs * a.in[11][layer * HD + d2], n1 = k1 * rs * a.in[11][layer * HD + d2 + 1];
        ok[127 * 128 + kvh * 64 + d2] = n0; ok[127 * 128 + kvh * 64 + d2 + 1] = n1;
        *(LAS unsigned*)(lds + SA_K + (144 * SA_ROW + kvh * 64 + d2) * 2) = pk2(n0, n1);
    } else if (wave == 1) {
        const int kvh = lane >> 5, d2 = (lane & 31) * 2;
        const unsigned vv2 = *(const unsigned*)(prow + C_VA + kvh * 64 + d2);
        ov[127 * 128 + kvh * 64 + d2] = bflo(vv2); ov[127 * 128 + kvh * 64 + d2 + 1] = bfhi(vv2);
        *(LAS unsigned*)(lds + SA_V + (144 * SA_ROW + kvh * 64 + d2) * 2) = vv2;
    }
    LAS float* Qs = (LAS float*)(lds + SA_Q) + wave * 64; LAS float* Ps = (LAS float*)(lds + SA_P) + wave * 160;
    { const float q = bf2f(prow[C_QA + wave * 64 + lane]); const float ssq = wave_sum(q * q);
      Qs[lane] = q * rsqrtf(ssq * (1.f / HD) + EPS) * a.in[10][layer * HD + lane] * 0.125f; }
    __syncthreads();
    const int kvh = wave >> 2; const float sink = a.in[12][layer * NQH + wave];
    float scv[3]; float mx = -1e30f;
#pragma unroll
    for (int r3 = 0; r3 < 3; ++r3) {
        const int j = lane + 64 * r3; float s = -1e30f;
        if (j < 145 && j != 16) {
            float acc = 0.f;
#pragma unroll
            for (int c = 0; c < 8; ++c) { const u32x4 kx = *(const LAS u32x4*)(lds + SA_K + (j * SA_ROW + kvh * 64 + c * 8) * 2);
                const LAS float* qp = Qs + c * 8;
                acc += qp[0] * bflo(kx.x) + qp[1] * bfhi(kx.x) + qp[2] * bflo(kx.y) + qp[3] * bfhi(kx.y) + qp[4] * bflo(kx.z) + qp[5] * bfhi(kx.z) + qp[6] * bflo(kx.w) + qp[7] * bfhi(kx.w); }
            s = acc;
        }
        scv[r3] = s; mx = fmaxf(mx, s);
    }
    mx = wave_max(mx);
    const float m = fmaxf(mx, sink);
    float sum = 0.f;
#pragma unroll
    for (int r3 = 0; r3 < 3; ++r3) { scv[r3] = __expf(scv[r3] - m); sum += scv[r3]; }
    sum = wave_sum(sum);
    const float inv = 1.f / (sum + __expf(sink - m));
#pragma unroll
    for (int r3 = 0; r3 < 3; ++r3) { const int j = lane + 64 * r3; if (j < 160) Ps[j] = scv[r3] * inv; }
    __syncthreads();
    float o = 0.f;
#pragma unroll 5
    for (int j = 0; j < 145; ++j) o += Ps[j] * bf2f(*(const LAS unsigned short*)(lds + SA_V + (j * SA_ROW + kvh * 64 + lane) * 2));
    const float ga = bf2f(prow[C_GA + wave * 64 + lane]);
    ((bf16*)(a.ws + WS_MIX))[row * DM + wave * 64 + lane] = (bf16)f2bf(o * silu_f(ga));
    __syncthreads();
}


constexpr int S2_ROW = 72, S2_K = 0, S2_V = 145 * S2_ROW * 2  , S2_Q = 41984, S2_P = S2_Q + 4 * 64 * 4  , S2_ST = S2_P + 4 * 160 * 4  , S2_O = S2_ST + 64  ;
__device__ __forceinline__ void sattn2(const Args& a, int layer, int unit, LAS unsigned char* lds) {
    int tid_ = threadIdx.x; asm volatile("" : "+v"(tid_)); const int tid = tid_, lane = tid & 63, wave = tid >> 6;
    const int seq = unit >> 1, kvh = unit & 1;
    const size_t cidx = (size_t)(seq * DEPTH + layer) * WIN * 128 + kvh * 64, midx = (size_t)(seq * DEPTH + layer) * NMETA * 128 + kvh * 64;
    const float* ck = a.in[2] + cidx; const float* cv = a.in[3] + cidx; const float* mk = a.in[4] + midx; const float* mv = a.in[5] + midx;
    float* ok = a.out + O_WKS + cidx; float* ov = a.out + O_WVS + cidx;
    const size_t row = MP + seq;
    const bf16* prow = (const bf16*)(a.ws + WS_P) + row * PW;
#pragma unroll
    for (int j = 0; j < 4; ++j) {
        const int idx = tid + NTHREADS * j, r = idx >> 4, c4 = (idx & 15) * 4;
        const f32x4 kx = __builtin_nontemporal_load((const f32x4*)(ck + r * 128 + c4)), vx = __builtin_nontemporal_load((const f32x4*)(cv + r * 128 + c4));
        if (r >= 1) { __builtin_nontemporal_store(kx, (f32x4*)(ok + (r - 1) * 128 + c4)); __builtin_nontemporal_store(vx, (f32x4*)(ov + (r - 1) * 128 + c4)); }
        *(LAS u32x2*)(lds + S2_K + ((16 + r) * S2_ROW + c4) * 2) = (u32x2){pk2(kx[0], kx[1]), pk2(kx[2], kx[3])};
        *(LAS u32x2*)(lds + S2_V + ((16 + r) * S2_ROW + c4) * 2) = (u32x2){pk2(vx[0], vx[1]), pk2(vx[2], vx[3])};
    }
    if (tid < 256) { const int r = tid >> 4, c4 = (tid & 15) * 4;
      const f32x4 kx = *(const f32x4*)(mk + r * 128 + c4), vx = *(const f32x4*)(mv + r * 128 + c4);
      *(LAS u32x2*)(lds + S2_K + (r * S2_ROW + c4) * 2) = (u32x2){pk2(kx[0], kx[1]), pk2(kx[2], kx[3])};
      *(LAS u32x2*)(lds + S2_V + (r * S2_ROW + c4) * 2) = (u32x2){pk2(vx[0], vx[1]), pk2(vx[2], vx[3])}; }
    if (wave == 4) {
        const int d2 = (lane & 31) * 2;
        const unsigned kk2 = *(const unsigned*)(prow + C_KA + kvh * 64 + d2);
        const float k0 = bflo(kk2), k1 = bfhi(kk2);
        float ssq = k0 * k0 + k1 * k1;
#pragma unroll
        for (int o = 1; o < 32; o <<= 1) ssq += __shfl_xor(ssq, o);
        const float rs = rsqrtf(ssq * (1.f / HD) + EPS);
        const float n0 = k0 * rs * a.in[11][layer * HD + d2], n1 = k1 * rs * a.in[11][layer * HD + d2 + 1];
        if (lane < 32) { ok[127 * 128 + d2] = n0; ok[127 * 128 + d2 + 1] = n1; *(LAS unsigned*)(lds + S2_K + (144 * S2_ROW + d2) * 2) = pk2(n0, n1); }
    } else if (wave == 5) {
        if (lane < 32) { const int d2 = lane * 2; const unsigned vv2 = *(const unsigned*)(prow + C_VA + kvh * 64 + d2);
            ov[127 * 128 + d2] = bflo(vv2); ov[127 * 128 + d2 + 1] = bfhi(vv2); *(LAS unsigned*)(lds + S2_V + (144 * S2_ROW + d2) * 2) = vv2; }
    }
    const int g = wave & 3, hf = wave >> 2, head = kvh * 4 + g;
    LAS float* Qs = (LAS float*)(lds + S2_Q) + g * 64; LAS float* Ps = (LAS float*)(lds + S2_P) + g * 160;
    LAS float* St = (LAS float*)(lds + S2_ST);
    LAS float* Op = (LAS float*)(lds + S2_O);
    if (hf == 0) { const float q = bf2f(prow[C_QA + head * 64 + lane]); const float ssq = wave_sum(q * q);
      Qs[lane] = q * rsqrtf(ssq * (1.f / HD) + EPS) * a.in[10][layer * HD + lane] * 0.125f; }
    __syncthreads();
    const float sink = a.in[12][layer * NQH + head];
    float scv[2]; float mx = -1e30f;
#pragma unroll
    for (int r2 = 0; r2 < 2; ++r2) {
        const int j = (hf == 0) ? lane + 128 * r2 : (r2 == 0 ? 64 + lane : 1000);
        float sc = -1e30f;
        if (j < 145 && j != 16) {
            float acc = 0.f;
#pragma unroll
            for (int c = 0; c < 8; ++c) { const u32x4 kx = *(const LAS u32x4*)(lds + S2_K + (j * S2_ROW + c * 8) * 2);
                const LAS float* qp = Qs + c * 8;
                acc += qp[0] * bflo(kx.x) + qp[1] * bfhi(kx.x) + qp[2] * bflo(kx.y) + qp[3] * bfhi(kx.y) + qp[4] * bflo(kx.z) + qp[5] * bfhi(kx.z) + qp[6] * bflo(kx.w) + qp[7] * bfhi(kx.w); }
            sc = acc;
        }
        scv[r2] = sc; mx = fmaxf(mx, sc);
    }
    mx = wave_max(mx);
    float sum = 0.f;
#pragma unroll
    for (int r2 = 0; r2 < 2; ++r2) { scv[r2] = __expf(scv[r2] - mx); sum += scv[r2]; }
    sum = wave_sum(sum);
    if (lane == 0) { St[(g * 2 + hf) * 2] = mx; St[(g * 2 + hf) * 2 + 1] = sum; }
    __syncthreads();
    {
        const float m0 = St[(g * 2 + 0) * 2], s0 = St[(g * 2 + 0) * 2 + 1], m1 = St[(g * 2 + 1) * 2], s1 = St[(g * 2 + 1) * 2 + 1];
        const float M = fmaxf(fmaxf(m0, m1), sink);
        const float inv = 1.f / (s0 * __expf(m0 - M) + s1 * __expf(m1 - M) + __expf(sink - M));
        const float sc = __expf(mx - M) * inv;
#pragma unroll
        for (int r2 = 0; r2 < 2; ++r2) { const int j = (hf == 0) ? lane + 128 * r2 : (r2 == 0 ? 64 + lane : 1000); if (j < 160) Ps[j] = scv[r2] * sc; }
    }
    __syncthreads();
    float o = 0.f;
    { const int j0 = hf ? 73 : 0, j1 = hf ? 145 : 73;
#pragma unroll 4
      for (int j = j0; j < j1; ++j) o += Ps[j] * bf2f(*(const LAS unsigned short*)(lds + S2_V + (j * S2_ROW + lane) * 2)); }
    if (hf == 1) Op[g * 64 + lane] = o;
    __syncthreads();
    if (hf == 0) {
        o += Op[g * 64 + lane];
        const float ga = bf2f(prow[C_GA + head * 64 + lane]);
        ((bf16*)(a.ws + WS_MIX))[row * DM + head * 64 + lane] = (bf16)f2bf(o * silu_f(ga));
    }
    __syncthreads();
}
constexpr int TAIL_ROW0 = 16384, TAIL_RT = (MS - TAIL_ROW0) / 16;
__device__ __forceinline__ void outproj_tail(const Args& a, int layer) {
    int tid_ = threadIdx.x; asm volatile("" : "+v"(tid_)); const int tid = tid_, lane = tid & 63, wave = tid >> 6, l15 = lane & 15, quad = lane >> 4;
    const int G = gridDim.x;
    const bf16* MIX = (const bf16*)(a.ws + WS_MIX); const bf16* W = (const bf16*)(a.ws + WS_WOUT) + (size_t)layer * DM * DM;
    bf16* XB = (bf16*)(a.ws + WS_XB); unsigned long long* ssn = (unsigned long long*)(a.ws + WS_SS) + (layer + 1 < DEPTH ? layer + 1 : 0) * MPAD;
    const int last = (layer == DEPTH - 1);
    for (int t = blockIdx.x + G * wave; t < TAIL_RT * 64; t += G * 8) {
        const int rt = t >> 6, ct = t & 63;
        const bf16* ap = MIX + (size_t)(TAIL_ROW0 + 16 * rt + l15) * DM + quad * 8;
        const bf16* bp = W + (size_t)(16 * ct + l15) * DM + quad * 8;
        f32x4 acc = {0.f, 0.f, 0.f, 0.f};
#pragma unroll 1
        for (int s0 = 0; s0 < 32; s0 += 8) {
            s16x8 af[8], bf[8];
#pragma unroll
            for (int u = 0; u < 8; ++u) { af[u] = *(const s16x8*)(ap + 32 * (s0 + u)); bf[u] = *(const s16x8*)(bp + 32 * (s0 + u)); }
#pragma unroll
            for (int u = 0; u < 8; ++u) acc = MFMA32(bf[u], af[u], acc);
        }
        const int row = TAIL_ROW0 + 16 * rt + l15, col = 16 * ct + quad * 4;
        const u32x2 xb = *(const u32x2*)(XB + (size_t)row * DM + col);
        const f32x4 v = (f32x4){bflo(xb.x), bfhi(xb.x), bflo(xb.y), bfhi(xb.y)} + acc;
        if (last) {
            float* yr = nullptr;
            if (row < MP) { const int b = row / LP, pos = row - b * LP; if (pos >= NMETA) yr = a.out + O_YP + ((size_t)b * SEQ + pos - NMETA) * DM + col; }
            else if (row < MS) yr = a.out + O_YS + (size_t)(row - MP) * DM + col;
            if (yr) *(f32x4*)yr = v;
        } else {
            *(u32x2*)(XB + (size_t)row * DM + col) = (u32x2){pk2(v[0], v[1]), pk2(v[2], v[3])};
            float part = v[0] * v[0] + v[1] * v[1] + v[2] * v[2] + v[3] * v[3];
            part += __shfl_xor(part, 16); part += __shfl_xor(part, 32);
            if (quad == 0) atomicAdd(ssn + row, (unsigned long long)(part * SS_SCALE));
        }
    }
}

#define XB_TMO      128
#define XB_XCNT(j)  (256  + 64 * (j))
#define XB_XSUB(j)  (1280 + 64 * (j))
#define XB_XGEN(j)  (2304 + 64 * (j))
#define XB_TOP      3328
#define XB_TOPGEN   3392
#define XCD_BAR_WORDS 3456
#define XB_SPIN_CAP (1u << 18)

__device__ __forceinline__ unsigned xb_ld(unsigned* p)              { return __hip_atomic_load(p, __ATOMIC_RELAXED, __HIP_MEMORY_SCOPE_AGENT); }
__device__ __forceinline__ unsigned xb_add(unsigned* p, unsigned v) { return __hip_atomic_fetch_add(p, v, __ATOMIC_RELAXED, __HIP_MEMORY_SCOPE_AGENT); }
__device__ __forceinline__ unsigned xb_xcc_id() { return (unsigned)__builtin_amdgcn_s_getreg((3 << 11) | 20) & 0xFu; }
#define XB_SPIN(cond, bar) do { unsigned _sp = 0; while (cond) { __builtin_amdgcn_s_sleep(1); \
    if ((++_sp & 255u) == 0u) { if (xb_ld(&(bar)[XB_TMO])) break; if (_sp > XB_SPIN_CAP) { atomicAdd(&(bar)[XB_TMO], 1u); break; } } } } while (0)

struct XcdBarrier {
    unsigned* bar; unsigned x;
    volatile LAS unsigned* st;
};

__device__ __forceinline__ XcdBarrier xcd_barrier_post(unsigned* bar, volatile LAS unsigned* st) {
    XcdBarrier b; b.bar = bar; b.x = xb_xcc_id(); b.st = st;
    if (threadIdx.x == 0) (void)xb_add(&bar[XB_XCNT(b.x)], 1u);
    return b;
}
__device__ __forceinline__ void xcd_barrier_complete(unsigned* bar, unsigned x, unsigned& nloc, unsigned& nx) {
    const unsigned G = gridDim.x * gridDim.y * gridDim.z;
    unsigned sum, cnt, mine, sp = 0u;
    for (;;) {
        sum = 0u; cnt = 0u; mine = 0u;
#pragma unroll
        for (unsigned j = 0; j < 16; ++j) { const unsigned c = xb_ld(&bar[XB_XCNT(j)]); sum += c; cnt += (c > 0u) ? 1u : 0u; mine = (j == x) ? c : mine; }
        if (sum == G) break;
        __builtin_amdgcn_s_sleep(1);
        if ((++sp & 255u) == 0u) { if (xb_ld(&bar[XB_TMO])) break; if (sp > XB_SPIN_CAP) { atomicAdd(&bar[XB_TMO], 1u); break; } }
    }
    nloc = mine > 0u ? mine : 1u; nx = cnt > 0u ? cnt : 1u;
}

__device__ __forceinline__ void xcd_barrier(const XcdBarrier& b) {
    asm volatile("s_waitcnt vmcnt(0)" ::: "memory");
    __syncthreads();
    if (threadIdx.x == 0) {
        unsigned* bar = b.bar;
        __builtin_amdgcn_s_waitcnt(0);
        unsigned nloc = b.st[0], nx = b.st[1];
        if (nloc == 0u) { xcd_barrier_complete(bar, b.x, nloc, nx); b.st[0] = nloc; b.st[1] = nx; }
        const unsigned old = xb_add(&bar[XB_XSUB(b.x)], 1u);
        const unsigned gen = old / nloc;
        if (old + 1u == (gen + 1u) * nloc) {
            __builtin_amdgcn_fence(__ATOMIC_RELEASE, "agent");
            asm volatile("s_waitcnt vmcnt(0)" ::: "memory");
            const unsigned og = xb_add(&bar[XB_TOP], 1u);
            const unsigned tg = og / nx;
            if (og + 1u == (tg + 1u) * nx) xb_add(&bar[XB_TOPGEN], 1u);
            else XB_SPIN(xb_ld(&bar[XB_TOPGEN]) == tg, bar);
            __builtin_amdgcn_fence(__ATOMIC_ACQUIRE, "agent");
            xb_add(&bar[XB_XGEN(b.x)], 1u);
            asm volatile("s_waitcnt vmcnt(0)" ::: "memory");
        } else {
            XB_SPIN(xb_ld(&bar[XB_XGEN(b.x)]) == gen, bar);
            __builtin_amdgcn_fence(__ATOMIC_ACQUIRE, "agent");
            asm volatile("s_waitcnt vmcnt(0)" ::: "memory");
        }
    }
    __syncthreads();
}

constexpr int N_PHASES = 1 + 5 * DEPTH;
__global__ void __launch_bounds__(NTHREADS, 2) hymba_fwd(Args a) {
    extern __shared__ __attribute__((aligned(16))) unsigned char lds_raw[];
    LAS unsigned char* lds = (LAS unsigned char*)lds_raw;
    const int G = gridDim.x, bx = blockIdx.x;
    if (threadIdx.x < 64) ((LAS unsigned*)(lds + MISC_OFF))[threadIdx.x] = 0u;
    __syncthreads();
    const XcdBarrier bar = xcd_barrier_post((unsigned*)(a.ws + WS_BAR), (volatile LAS unsigned*)(lds + MISC_OFF));
#ifndef REP_A
#define REP_A 1
#endif
#ifndef REP_P
#define REP_P 1
#endif
#ifndef REP_B
#define REP_B 1
#endif
#ifndef REP_B1
#define REP_B1 1
#endif
#ifndef REP_B2
#define REP_B2 1
#endif
#ifndef REP_B3
#define REP_B3 1
#endif
#ifndef REP_C
#define REP_C 1
#endif
#ifndef REP_D
#define REP_D 1
#endif
    for (int ph = a.ph_lo; ph < a.ph_hi; ++ph) {
#ifndef PHM
#define PHM 0xff
#endif
        if (ph == 0) { for (int rep = 0; rep < REP_P; ++rep) prologue(a, lds); }
        else {
            const int layer = (ph - 1) / 5, st = (ph - 1) % 5;
            if (st == 0) {
                { const int nun0 = (MPAD / 256) * (PW / 256), first0 = (G == 256) ? (nun0 - 3 * 256) : 0;
                  convert_layer(a, layer, first0, lds); __syncthreads(); }
                if (PHM & 2) for (int rep = 0; rep < REP_A; ++rep) {
                pg8::Gemm g{(const pg8::bf16_t*)(a.ws + WS_XB), (const pg8::bf16_t*)(a.ws + WS_WIN) + (size_t)layer * PW * DM, MPAD, PW, DM};
                pg8::StaticOrder S; S.init(MPAD, PW, G, bx);
                EpiP E{(bf16*)(a.ws + WS_P), (const unsigned long long*)(a.ws + WS_SS) + layer * MPAD};
                pg8::gemm_phase<EpiP, pg8::StaticOrder, true, true>(lds, g, S, E); }
                { const int nun = (MPAD / 256) * (PW / 256), first = (G == 256) ? (nun - 3 * 256) : 0;
                }
            } else if (st == 1) {
                const bool first = (bx & 1) == 0;
                const int slot3 = bx % 3; const bool mid = (slot3 == 1);
                const int vb = (G % 8 == 0) ? (bx % 8) * (G / 8) + bx / 8 : bx;
                if (slot3 == 0) { for (int u = bx; u < DB * NKV; u += G) sattn2(a, layer, u, lds);
                    if (G == 256) hg_sample2(a, layer, bx, bx + 256, lds); else for (int u = bx; u < DB * HGH; u += G) hg_sample(a, layer, u, lds); }
                for (int u = vb; u < NB * 65 * NKV; u += G) pattn(a, layer, u, lds);
                if (mid) { for (int u = bx; u < DB * NKV; u += G) sattn2(a, layer, u, lds); hg_sample2(a, layer, bx, bx + 256, lds); }
                for (int u = vb; u < NB * HGH * NSC; u += G) hg_pass1(a, layer, u, lds);
                if (slot3 == 2) { for (int u = bx; u < DB * NKV; u += G) sattn2(a, layer, u, lds);
                    if (G == 256) hg_sample2(a, layer, bx, bx + 256, lds); else for (int u = bx; u < DB * HGH; u += G) hg_sample(a, layer, u, lds); }
            } else if (st == 2) { for (int rep = 0; rep < REP_C; ++rep) {
                hg_scan(a, layer);
                }
            } else if (st == 3) { for (int rep = 0; rep < REP_D; ++rep)
                for (int u = (G % 8 == 0) ? (bx % 8) * (G / 8) + bx / 8 : bx; u < NB * HGH * NSC; u += G) hg_pass2(a, layer, u, lds);
            } else if (PHM & 128) {
                constexpr int EM = TAIL_ROW0;
                if ((bx & 1) == 0) outproj_tail(a, layer);
                pg8::Gemm g{(const pg8::bf16_t*)(a.ws + WS_MIX), (const pg8::bf16_t*)(a.ws + WS_WOUT) + (size_t)layer * DM * DM, EM, DM, DM};
                pg8::StaticOrder S; S.init(EM, DM, G, bx);
                const int last = (layer == DEPTH - 1);
                EpiOut E{(bf16*)(a.ws + WS_XB), (unsigned long long*)(a.ws + WS_SS) + (layer + 1 < DEPTH ? layer + 1 : 0) * MPAD, a.out, last};
                pg8::gemm_phase<EpiOut, pg8::StaticOrder, true, true>(lds, g, S, E);
                if (bx & 1) outproj_tail(a, layer);
            }
        }
        if (ph + 1 < a.ph_hi) { if (a.ph_hi > 1000) cg::this_grid().sync(); else xcd_barrier(bar); }
    }
}

#ifndef MK_MULTI
#define MK_MULTI 0
#endif
extern "C" void kernel_launch(void* const* d_in, const int* in_sizes, int n_in, void* d_out, int out_size, void* d_ws, size_t ws_size, hipStream_t stream) {
    static int grid = 0;
    if (grid == 0) {
        if (n_in != 16 || (size_t)out_size != O_END || ws_size < WS_END) { fprintf(stderr, "kernel_launch: unexpected shapes (n_in %d out %d ws %zu)\n", n_in, out_size, ws_size); grid = -1; return; }
        int dev = 0, cus = 0, per_cu = 0;
        hipGetDevice(&dev); hipDeviceGetAttribute(&cus, hipDeviceAttributeMultiprocessorCount, dev);
        if (hipFuncSetAttribute((const void*)hymba_fwd, hipFuncAttributeMaxDynamicSharedMemorySize, LDS_BYTES) != hipSuccess) { fprintf(stderr, "kernel_launch: hipFuncSetAttribute failed\n"); grid = -1; return; }
        if (hipOccupancyMaxActiveBlocksPerMultiprocessor(&per_cu, (const void*)hymba_fwd, NTHREADS, LDS_BYTES) != hipSuccess || per_cu < 1) per_cu = 1;
        (void)hipGetLastError();
        grid = cus * 1;
        if (grid <= 0) grid = 256;
        if (grid != 256) { fprintf(stderr, "kernel_launch: built for a 256-CU device (one HGRN2 unit per workgroup); got %d CUs\n", grid); grid = -1; return; }
    }
    if (grid < 0) return;
    hipMemsetAsync((char*)d_ws + WS_SS, 0, CTL_ZERO_BYTES, stream);
    Args a{};
    for (int i = 0; i < 16; ++i) a.in[i] = (const float*)d_in[i];
    a.out = (float*)d_out; a.ws = (unsigned char*)d_ws;
#if MK_MULTI
    for (int ph = 0; ph < N_PHASES; ++ph) { a.ph_lo = ph; a.ph_hi = ph + 1; hipLaunchKernelGGL(hymba_fwd, dim3(grid), dim3(NTHREADS), LDS_BYTES, stream, a); }
#else
    a.ph_lo = 0; a.ph_hi = N_PHASES;
    void* args[] = {&a};
    hipError_t e = hipLaunchCooperativeKernel((const void*)hymba_fwd, dim3(grid), dim3(NTHREADS), args, LDS_BYTES, stream);
    if (e != hipSuccess) fprintf(stderr, "cooperative launch failed: %s (grid %d)\n", hipGetErrorString(e), grid);
#endif
}
```
